# Optimizing an MI355X kernel written in HIP

```python
import jax, jax.numpy as jnp
from jax import lax
import numpy as np

D_MODEL = 2048
BATCH = 8
SEQ = 4096
DEPTH = 2

CHUNK = 64
Q_BLOCK = 128
HEAD_DIM = 128
N_HEADS = D_MODEL // HEAD_DIM
N_FOX = N_HEADS // 2
N_SB = N_HEADS - N_FOX
N_DSA = N_HEADS
IDX_HEADS = 16
IDX_DIM = 64
TOPK_MAX = 256
D_FF = 4 * D_MODEL
ROPE_THETA = 10000.0
EPS = 1e-6
MIX_WIDTH = N_HEADS * HEAD_DIM
N_EVEN = (DEPTH + 1) // 2
N_ODD = DEPTH // 2
EVEN_SPLITS = [N_FOX * HEAD_DIM, 2 * N_FOX * HEAD_DIM, 3 * N_FOX * HEAD_DIM,
               3 * N_FOX * HEAD_DIM + N_FOX,
               3 * N_FOX * HEAD_DIM + N_FOX + N_SB * HEAD_DIM,
               3 * N_FOX * HEAD_DIM + N_FOX + 2 * N_SB * HEAD_DIM]
EVEN_WIDTH = 3 * N_FOX * HEAD_DIM + N_FOX + 3 * N_SB * HEAD_DIM
ODD_SPLITS = [N_DSA * HEAD_DIM, N_DSA * HEAD_DIM + HEAD_DIM, N_DSA * HEAD_DIM + 2 * HEAD_DIM,
              N_DSA * HEAD_DIM + 2 * HEAD_DIM + IDX_HEADS * IDX_DIM,
              N_DSA * HEAD_DIM + 2 * HEAD_DIM + IDX_HEADS * IDX_DIM + IDX_DIM]
ODD_WIDTH = N_DSA * HEAD_DIM + 2 * HEAD_DIM + IDX_HEADS * IDX_DIM + IDX_DIM + IDX_HEADS

kernel_name = "hybrid_fox_stickbreak_dsa_trunk"


def rms_norm(x, g):
    xf = x.astype(jnp.float32)
    y = xf * lax.rsqrt(jnp.mean(xf * xf, axis=-1, keepdims=True) + EPS)
    return (y * g.astype(jnp.float32)).astype(x.dtype)


def rope(x, pos):
    half = x.shape[-1] // 2
    inv = ROPE_THETA ** (-jnp.arange(half, dtype=jnp.float32) / half)
    ang = pos.astype(jnp.float32)[..., None] * inv
    cos = jnp.cos(ang)[:, :, None, :]
    sin = jnp.sin(ang)[:, :, None, :]
    xf = x.astype(jnp.float32)
    x1, x2 = xf[..., :half], xf[..., half:]
    return jnp.concatenate([x1 * cos - x2 * sin, x2 * cos + x1 * sin], axis=-1).astype(x.dtype)


def fox_sb_mixer(h, w_in, b_forget):
    B, S, _ = h.shape
    proj = h @ w_in
    fq, fk, fv, fg, sq, sk, sv = jnp.split(proj, EVEN_SPLITS, axis=-1)
    fq, fk, fv = (a.reshape(B, S, N_FOX, HEAD_DIM) for a in (fq, fk, fv))
    sq, sk, sv = (a.reshape(B, S, N_SB, HEAD_DIM) for a in (sq, sk, sv))
    log_f = jax.nn.log_sigmoid(fg.astype(jnp.float32) + b_forget.astype(jnp.float32))
    F = jnp.cumsum(log_f, axis=1).transpose(0, 2, 1)
    scale = HEAD_DIM ** -0.5
    outs_f, outs_s = [], []
    for q0 in range(0, S, Q_BLOCK):
        q1 = q0 + Q_BLOCK
        t = jnp.arange(q0, q1)[:, None]
        s = jnp.arange(q1)[None, :]
        logit = jnp.einsum('bthd,bshd->bhts', fq[:, q0:q1], fk[:, :q1]).astype(jnp.float32) * scale
        decay = F[:, :, q0:q1, None] - F[:, :, None, :q1]
        logit = jnp.where(s <= t, logit + decay, -jnp.inf)
        p = jax.nn.softmax(logit, axis=-1).astype(h.dtype)
        outs_f.append(jnp.einsum('bhts,bshd->bthd', p, fv[:, :q1]))
        z = jnp.einsum('bthd,bshd->bhts', sq[:, q0:q1], sk[:, :q1]).astype(jnp.float32) * scale
        strict = s < t
        log_1mb = jnp.where(strict, jax.nn.log_sigmoid(-z), 0.0)
        suffix = lax.cumsum(log_1mb, axis=3, reverse=True) - log_1mb
        A = jnp.where(strict, jnp.exp(jax.nn.log_sigmoid(z) + suffix), 0.0).astype(h.dtype)
        outs_s.append(jnp.einsum('bhts,bshd->bthd', A, sv[:, :q1]))
    o_f = jnp.concatenate(outs_f, axis=1).reshape(B, S, N_FOX * HEAD_DIM)
    o_s = jnp.concatenate(outs_s, axis=1).reshape(B, S, N_SB * HEAD_DIM)
    return jnp.concatenate([o_f, o_s], axis=-1)


def dsa_mixer(h, w_in, pos):
    B, S, _ = h.shape
    topk = min(TOPK_MAX, S // 4)
    proj = h @ w_in
    q, k, v, qi, ki, wi = jnp.split(proj, ODD_SPLITS, axis=-1)
    q = rope(q.reshape(B, S, N_DSA, HEAD_DIM), pos)
    k = rope(k.reshape(B, S, 1, HEAD_DIM), pos)[:, :, 0]
    qi = rope(qi.reshape(B, S, IDX_HEADS, IDX_DIM), pos)
    ki = rope(ki.reshape(B, S, 1, IDX_DIM), pos)[:, :, 0]
    wi = wi.astype(jnp.float32) * (IDX_HEADS ** -0.5)
    gather = jax.vmap(lambda tab, idx: tab[idx])
    scale = HEAD_DIM ** -0.5
    outs = []
    for q0 in range(0, S, Q_BLOCK):
        q1 = q0 + Q_BLOCK
        Lk = min(S, max(q1, topk))
        t = jnp.arange(q0, q1)
        s = jnp.arange(Lk)
        adm = (s // CHUNK)[None, :] <= (t // CHUNK)[:, None]
        isc = jnp.einsum('bthd,bsd->bths', qi[:, q0:q1], ki[:, :Lk]).astype(jnp.float32) * (IDX_DIM ** -0.5)
        I = jnp.einsum('bths,bth->bts', jax.nn.relu(isc), wi[:, q0:q1])
        I = jnp.where(adm[None], I, -jnp.inf)
        vals, idx = lax.top_k(I, topk)
        valid = jnp.isfinite(vals)
        ksel = gather(k, idx)
        vsel = gather(v, idx)
        sc = jnp.einsum('bthd,btkd->bthk', q[:, q0:q1], ksel).astype(jnp.float32) * scale
        sc = jnp.where(valid[:, :, None, :], sc, -jnp.inf)
        p = jax.nn.softmax(sc, axis=-1).astype(h.dtype)
        outs.append(jnp.einsum('bthk,btkd->bthd', p, vsel))
    return jnp.concatenate(outs, axis=1).reshape(B, S, N_DSA * HEAD_DIM)


def setup_inputs(seed: int = 0) -> dict:
    key = jax.random.key(seed)
    ks = jax.random.split(key, 16)
    f32 = jnp.float32
    x = jax.random.normal(ks[0], (BATCH, SEQ, D_MODEL), f32)
    c = jax.random.normal(ks[1], (BATCH, D_MODEL), f32)
    offset = jax.random.randint(ks[2], (BATCH, 1), 0, 4096, dtype=jnp.int32)
    positions = (offset + jnp.arange(SEQ, dtype=jnp.int32)[None, :]).astype(jnp.int32)
    ada_w = jax.random.normal(ks[3], (DEPTH, D_MODEL, 6 * D_MODEL), f32) * (0.5 * D_MODEL ** -0.5)
    ada_b = jax.random.normal(ks[4], (DEPTH, 6 * D_MODEL), f32) * 0.02
    norm_g = 1.0 + 0.1 * jax.random.normal(ks[5], (DEPTH, 4, D_MODEL), f32)
    mix_w_out = jax.random.normal(ks[6], (DEPTH, MIX_WIDTH, D_MODEL), f32) * (MIX_WIDTH ** -0.5)
    even_w_in = jax.random.normal(ks[7], (N_EVEN, D_MODEL, EVEN_WIDTH), f32) * (D_MODEL ** -0.5)
    even_b_forget = 3.0 + 0.5 * jax.random.normal(ks[8], (N_EVEN, N_FOX), f32)
    odd_w_in = jax.random.normal(ks[9], (N_ODD, D_MODEL, ODD_WIDTH), f32) * (D_MODEL ** -0.5)
    ff_w1 = jax.random.normal(ks[10], (DEPTH, D_MODEL, D_FF), f32) * (D_MODEL ** -0.5)
    ff_w2 = jax.random.normal(ks[11], (DEPTH, D_FF, D_MODEL), f32) * (D_FF ** -0.5)
    return {"x": x, "c": c, "positions": positions, "ada_w": ada_w, "ada_b": ada_b,
            "norm_g": norm_g, "mix_w_out": mix_w_out, "even_w_in": even_w_in,
            "even_b_forget": even_b_forget, "odd_w_in": odd_w_in,
            "ff_w1": ff_w1, "ff_w2": ff_w2}


def reference(x, c, positions, ada_w, ada_b, norm_g, mix_w_out, even_w_in,
              even_b_forget, odd_w_in, ff_w1, ff_w2):
    cs = jax.nn.silu(c)
    for l in range(DEPTH):
        mod = (cs @ ada_w[l] + ada_b[l])[:, None, :]
        sh_a, sc_a, g_a, sh_m, sc_m, g_m = jnp.split(mod, 6, axis=-1)
        h = rms_norm(x, norm_g[l, 0]) * (1.0 + sc_a) + sh_a
        if l % 2 == 0:
            o = fox_sb_mixer(h, even_w_in[l // 2], even_b_forget[l // 2])
        else:
            o = dsa_mixer(h, odd_w_in[l // 2], positions)
        x = x + g_a * rms_norm(o @ mix_w_out[l], norm_g[l, 1])
        h = rms_norm(x, norm_g[l, 2]) * (1.0 + sc_m) + sh_m
        y = jnp.square(jax.nn.relu(h @ ff_w1[l])) @ ff_w2[l]
        x = x + g_m * rms_norm(y, norm_g[l, 3])
    return x
```

```cpp
#include <hip/hip_runtime.h>
#include <hip/hip_bf16.h>
#include <cstdio>
#include <cstdint>
#ifndef MK_PER_PHASE
#define MK_PER_PHASE 0
#endif
#ifndef MK_DIAG
#define MK_DIAG 0
#endif
#ifndef DIAG_SET
#define DIAG_SET 0
#endif
#ifndef SYN_A
#define SYN_A 0
#define SYN_B 5
#define SYN_C 12
#endif
#ifndef MK_DOUBLE
#define MK_DOUBLE (-1)
#endif
#ifndef DSA_DUP
#define DSA_DUP 0
#endif
#ifndef PG8_ALIGN
#define PG8_ALIGN true
#endif
#ifndef PG8_SP2
#define PG8_SP2 true
#endif
#ifndef HID_AUX
#define HID_AUX 2
#endif
#ifndef STAG_IN
#define STAG_IN 16
#define STAG_FF1 16
#define STAG_Y 0
#endif
#ifndef RELAX_EPI
#define RELAX_EPI 1
#endif
#ifndef L1_I8
#define L1_I8 3
#endif
#ifndef L0_I8
#define L0_I8 2
#endif
#ifndef IN0_I8
#define IN0_I8 1
#endif
#ifndef FOX_WIN
#define FOX_WIN 1
#endif
#ifndef X16
#define X16 1
#endif
#ifndef IN1_I8
#define IN1_I8 1
#endif
#ifndef DSA_K8
#define DSA_K8 1
#endif
#ifndef WQ_SIGMA
#define WQ_SIGMA 1
#endif
#ifndef HID_U8
#define HID_U8 1
#endif
#ifndef FFN2_FP8
#define FFN2_FP8 0
#endif
__device__ __forceinline__ unsigned pk_i8x4(float a, float b, float c, float d, float qs) {
    const unsigned ua = __builtin_bit_cast(unsigned, __builtin_fmaf(a, qs, 12582912.f)), ub = __builtin_bit_cast(unsigned, __builtin_fmaf(b, qs, 12582912.f));
    const unsigned uc = __builtin_bit_cast(unsigned, __builtin_fmaf(c, qs, 12582912.f)), ud = __builtin_bit_cast(unsigned, __builtin_fmaf(d, qs, 12582912.f));
    return __builtin_amdgcn_perm(ub, ua, 0x0c0c0400u) | __builtin_amdgcn_perm(ud, uc, 0x04000c0cu);
}
__device__ __forceinline__ unsigned pk_i8x4s(float a, float b, float c, float d, float qs, float& sq) {
    const float fa = __builtin_amdgcn_fmed3f(a * qs, -127.f, 127.f) + 12582912.f, fb = __builtin_amdgcn_fmed3f(b * qs, -127.f, 127.f) + 12582912.f;
    const float fc = __builtin_amdgcn_fmed3f(c * qs, -127.f, 127.f) + 12582912.f, fd = __builtin_amdgcn_fmed3f(d * qs, -127.f, 127.f) + 12582912.f;
    const float ra = fa - 12582912.f, rb = fb - 12582912.f, rc = fc - 12582912.f, rd = fd - 12582912.f; sq += (ra * ra + rb * rb) + (rc * rc + rd * rd);
    return __builtin_amdgcn_perm(__builtin_bit_cast(unsigned, fb), __builtin_bit_cast(unsigned, fa), 0x0c0c0400u) | __builtin_amdgcn_perm(__builtin_bit_cast(unsigned, fd), __builtin_bit_cast(unsigned, fc), 0x04000c0cu);
}
#undef MK_PER_PHASE
#define MK_PER_PHASE 0
namespace pg8 {
#define PG8_LAS __attribute__((address_space(3)))
typedef unsigned short bf16_t;
typedef short bf16x8 __attribute__((ext_vector_type(8)));
typedef _Float16 h16x8 __attribute__((ext_vector_type(8)));
typedef float f32x4 __attribute__((ext_vector_type(4)));
typedef unsigned u32x4 __attribute__((ext_vector_type(4)));
typedef int i32x8 __attribute__((ext_vector_type(8)));
__device__ __forceinline__ i32x8 cat8(bf16x8 a, bf16x8 b) { const u32x4 x = __builtin_bit_cast(u32x4, a), y = __builtin_bit_cast(u32x4, b); return (i32x8){(int)x.x, (int)x.y, (int)x.z, (int)x.w, (int)y.x, (int)y.y, (int)y.z, (int)y.w}; }
constexpr int BM = 256, BK = 64, HALF = 128, HTB = HALF * BK * 2  , STAGE_BYTES = 8 * HTB, NXCD = 8, WGM = 8;

__host__ __device__ __forceinline__ int lds_byte(int r, int c) { const int st = (r >> 4) * 2 + (c >> 5), rr = r & 15, cc = c & 31, ob = rr * 64 + cc * 2; return st * 1024 + (ob ^ (((ob >> 9) & 1) << 5)); }
__host__ __device__ __forceinline__ void stage_rc(int b, int& R, int& C) { const int st = b / 1024, sb = b % 1024, swz = sb ^ (((sb >> 9) & 1) << 5); R = (st >> 1) * 16 + swz / 64; C = (st & 1) * 32 + (swz % 64) / 2; }
__host__ __device__ __forceinline__ int perm32(int rho) { const int n = rho >> 4, i = rho & 15; return 8 * (i >> 2) + 4 * n + (i & 3); }

struct Unit { int pm, pn; };
struct Gemm { const bf16_t* A; const bf16_t* Bt; int M, N, K; };

struct StaticOrder {
    int nM, nN, nwg, G, c;
    __host__ __device__ void init(int M, int N, int G_, int c_) { nM = M / BM; nN = N / BM; nwg = nM * nN; G = G_; c = c_; }
    __host__ __device__ bool next(int i, Unit& u) const { return at((long)i * G + c, u); }
    __host__ __device__ bool at(long L, Unit& u) const {
        if (L >= nwg) return false;
        int wgid = (int)L; { const int q = nwg / NXCD, r = nwg % NXCD, xcd = wgid % NXCD, off = wgid / NXCD; wgid = (xcd < r ? xcd * (q + 1) : r * (q + 1) + (xcd - r) * q) + off; }
        const int nig = WGM * nN, gid = wgid / nig, fm = gid * WGM, gsz = (nM - fm) < WGM ? (nM - fm) : WGM;
        u.pm = fm + ((wgid % nig) % gsz); u.pn = (wgid % nig) / gsz; return true;
    }
    __device__ __forceinline__ void a_ready(const Unit&) const {}
    __device__ __forceinline__ void done(const Unit&) const {}
};
struct DealOrder {
    StaticOrder S; int c, G;
    __host__ __device__ void init(int M, int N, int G_, int c_) { S.init(M, N, G_, c_); c = c_; G = G_; }
    __host__ __device__ bool next(int i, Unit& u) const {
        if (G != 256 || S.nwg != 1152) return S.next(i, u);
        if (i < 4) return S.at((long)i * 256 + c, u);
        if (i == 4 && c >= 128) return S.at(1024 + (c - 128), u);
        return false;
    }
    __device__ __forceinline__ void a_ready(const Unit&) const {}
    __device__ __forceinline__ void done(const Unit&) const {}
};

__device__ __forceinline__ unsigned cvt_pk_bf16(float lo, float hi) { unsigned r; asm volatile("v_cvt_pk_f16_f32 %0, %1, %2" : "=v"(r) : "v"(lo), "v"(hi)); return r; }
__device__ __forceinline__ void store_rowpair(bf16_t* O, int ldc, int row, int col0, bool odd, u32x4 w0, u32x4 w1) {
    const u32x4 give = odd ? w0 : w1; u32x4 got;
    got.x = (unsigned)__shfl_xor((int)give.x, 1); got.y = (unsigned)__shfl_xor((int)give.y, 1); got.z = (unsigned)__shfl_xor((int)give.z, 1); got.w = (unsigned)__shfl_xor((int)give.w, 1);
    const int re = row - (odd ? 1 : 0);
    bf16_t* p = O + (size_t)re * ldc + col0 + (odd ? 32 : 0);
    *(u32x4*)p = odd ? got : w0;
    *(u32x4*)(p + ldc) = odd ? w1 : got;
}
template <int ACT, bool BLK = false> struct EpiBf16 {
    static constexpr bool PERM = true, AFTER_DRAIN = false;
    bf16_t* O; int ldc; int c_lo, c_hi; float scale; const int* cs = nullptr; const float* rinv = nullptr; const float* winv = nullptr;
    __device__ __forceinline__ void operator()(const f32x4 (&acc)[2][2][4][2], const Unit& u, int wr, int wc, int fr_in, int fq_in) const {
        int fr = fr_in, fq = fq_in; asm volatile("" : "+v"(fr), "+v"(fq));
        const int row0 = u.pm * BM + wr * 64 + fr; const int col0 = u.pn * BM + wc * 64 + 8 * fq;
        typedef int i4c_ __attribute__((ext_vector_type(4)));
        i4c_ cadd[2][2] = {};
        if (ACT == 5) {
#pragma unroll
            for (int bj = 0; bj < 2; ++bj) { cadd[bj][0] = *(const i4c_*)(cs + col0 + bj * 32) * 128; cadd[bj][1] = *(const i4c_*)(cs + col0 + bj * 32 + 4) * 128; } }
        const __amdgpu_buffer_rsrc_t rsrc = __builtin_amdgcn_make_buffer_rsrc((void*)O, 0, 0x7fffffff, 0x00020000);
        const bool odd = fr & 1;
        float rs8[2][4];
        if (ACT == 6) { const float wi = winv[0];
#pragma unroll
            for (int ai = 0; ai < 2; ++ai)
#pragma unroll
                for (int m = 0; m < 4; ++m) rs8[ai][m] = rinv[row0 + ai * HALF + m * 16] * wi; }
#pragma unroll
        for (int ai = 0; ai < 2; ++ai)
#pragma unroll
            for (int m = 0; m < 4; ++m) { const int row = row0 + ai * HALF + m * 16; u32x4 w[2];
                float rsc = 1.f; if (ACT == 6) rsc = rs8[ai][m];
#pragma unroll
                for (int bj = 0; bj < 2; ++bj) { f32x4 v0 = acc[ai][bj][m][0], v1 = acc[ai][bj][m][1];
                    if (ACT == 6) { typedef int i4_ __attribute__((ext_vector_type(4)));
                        const int cb = col0 + bj * 32; const float sc = ((cb >= c_lo && cb < c_hi) ? scale : 1.f) * rsc;
                        v0 = __builtin_convertvector(__builtin_bit_cast(i4_, v0), f32x4) * sc; v1 = __builtin_convertvector(__builtin_bit_cast(i4_, v1), f32x4) * sc; }
                    else if (ACT == 2) { typedef int i4_ __attribute__((ext_vector_type(4)));
                        v0 = __builtin_convertvector(__builtin_bit_cast(i4_, v0), f32x4) * 0x1p-15f; v1 = __builtin_convertvector(__builtin_bit_cast(i4_, v1), f32x4) * 0x1p-15f;
                        v0 = __builtin_elementwise_max(v0, (f32x4){0.f, 0.f, 0.f, 0.f}); v1 = __builtin_elementwise_max(v1, (f32x4){0.f, 0.f, 0.f, 0.f}); v0 = v0 * v0; v1 = v1 * v1;
                        v0 = __builtin_elementwise_min(v0, (f32x4){60000.f, 60000.f, 60000.f, 60000.f}); v1 = __builtin_elementwise_min(v1, (f32x4){60000.f, 60000.f, 60000.f, 60000.f}); }
                    else if (ACT == 4 || ACT == 5) { typedef int i4_ __attribute__((ext_vector_type(4)));
                        i4_ a0 = __builtin_bit_cast(i4_, v0), a1 = __builtin_bit_cast(i4_, v1); if (ACT == 5) { a0 += cadd[bj][0]; a1 += cadd[bj][1]; }
                        v0 = __builtin_convertvector(a0, f32x4) * (ACT == 5 ? 0x1p-13f : 0x1p-12f); v1 = __builtin_convertvector(a1, f32x4) * (ACT == 5 ? 0x1p-13f : 0x1p-12f); }
                    else if (ACT == 1) { v0 = __builtin_elementwise_max(v0, (f32x4){0.f, 0.f, 0.f, 0.f}); v1 = __builtin_elementwise_max(v1, (f32x4){0.f, 0.f, 0.f, 0.f}); v0 = v0 * v0; v1 = v1 * v1; }
                    else { const int cb = col0 + bj * 32; const float sc = (cb >= c_lo && cb < c_hi) ? scale : 1.f; v0 = v0 * sc; v1 = v1 * sc; }
                    w[bj].x = cvt_pk_bf16(v0[0], v0[1]); w[bj].y = cvt_pk_bf16(v0[2], v0[3]); w[bj].z = cvt_pk_bf16(v1[0], v1[1]); w[bj].w = cvt_pk_bf16(v1[2], v1[3]); }
                if (BLK) {
#pragma unroll
                    for (int bj = 0; bj < 2; ++bj) { const unsigned r_ = (unsigned)row, c_ = (unsigned)(col0 + bj * 32);
                        __builtin_amdgcn_raw_buffer_store_b128(w[bj], rsrc, ((r_ >> 4) * (unsigned)(ldc >> 5) + (c_ >> 5)) * 1024u + (unsigned)(fr * 64 + fq * 16), 0, (ACT == 1 || ACT == 2) ? 2 : 0); } }
                else store_rowpair(O, ldc, row, col0, odd, w[0], w[1]); }
    }
};
struct EpiF8Hid {
    static constexpr bool PERM = true, AFTER_DRAIN = false;
    unsigned char* O; int kbytes;
    __device__ __forceinline__ void operator()(const f32x4 (&acc)[2][2][4][2], const Unit& u, int wr, int wc, int fr_in, int fq_in) const {
        int fr = fr_in, fq = fq_in; asm volatile("" : "+v"(fr), "+v"(fq));
        const int row0 = u.pm * BM + wr * 64 + fr; const unsigned blkcol = (unsigned)(u.pn * 4 + wc);
        const __amdgpu_buffer_rsrc_t rsrc = __builtin_amdgcn_make_buffer_rsrc((void*)O, 0, 0x7fffffff, 0x00020000);
        const bool odd = fq & 1;
#pragma unroll
        for (int ai = 0; ai < 2; ++ai)
#pragma unroll
            for (int m = 0; m < 4; ++m) { const unsigned row = (unsigned)(row0 + ai * HALF + m * 16); unsigned pc[2][2];
#pragma unroll
                for (int bj = 0; bj < 2; ++bj) { f32x4 v0 = acc[ai][bj][m][0], v1 = acc[ai][bj][m][1];
                    v0 = __builtin_elementwise_max(v0, (f32x4){0.f, 0.f, 0.f, 0.f}); v1 = __builtin_elementwise_max(v1, (f32x4){0.f, 0.f, 0.f, 0.f}); v0 = v0 * v0 * 2.f; v1 = v1 * v1 * 2.f;
                    unsigned d0 = 0u, d1 = 0u;
                    d0 = (unsigned)__builtin_amdgcn_cvt_pk_fp8_f32(v0[0], v0[1], (int)d0, false); d0 = (unsigned)__builtin_amdgcn_cvt_pk_fp8_f32(v0[2], v0[3], (int)d0, true);
                    d1 = (unsigned)__builtin_amdgcn_cvt_pk_fp8_f32(v1[0], v1[1], (int)d1, false); d1 = (unsigned)__builtin_amdgcn_cvt_pk_fp8_f32(v1[2], v1[3], (int)d1, true);
                    pc[bj][0] = d0; pc[bj][1] = d1; }
                unsigned a0 = pc[0][0], b0_ = pc[1][0], a1 = pc[0][1], b1_ = pc[1][1];
                asm volatile("s_nop 1\n\tv_permlane16_swap_b32 %0, %1\n\tv_permlane16_swap_b32 %2, %3\n\ts_nop 1" : "+v"(a0), "+v"(b0_), "+v"(a1), "+v"(b1_));
                u32x4 w; w.x = a0; w.y = a1; w.z = b0_; w.w = b1_;
                const unsigned unit = (odd ? 2u : 0u) + (unsigned)(fq >> 1);
                __builtin_amdgcn_raw_buffer_store_b128(w, rsrc, ((row >> 4) * (unsigned)(kbytes >> 6) + blkcol) * 1024u + (unsigned)fr * 64u + unit * 16u, 0, 2); }
    }
};
struct EpiI8Hid {
    static constexpr bool PERM = true, AFTER_DRAIN = false;
    unsigned char* O; int kbytes; const float* rs;
    __device__ __forceinline__ void operator()(const f32x4 (&acc)[2][2][4][2], const Unit& u, int wr, int wc, int fr_in, int fq_in) const {
        int fr = fr_in, fq = fq_in; asm volatile("" : "+v"(fr), "+v"(fq));
        typedef int i4_ __attribute__((ext_vector_type(4)));
        const int row0 = u.pm * BM + wr * 64 + fr; const unsigned blkcol = (unsigned)(u.pn * 4 + wc);
        const __amdgpu_buffer_rsrc_t rsrc = __builtin_amdgcn_make_buffer_rsrc((void*)O, 0, 0x7fffffff, 0x00020000);
        const bool odd = fq & 1;
        float rs8[2][4];
#pragma unroll
        for (int ai = 0; ai < 2; ++ai)
#pragma unroll
            for (int m = 0; m < 4; ++m) rs8[ai][m] = __builtin_amdgcn_sqrtf(rs[row0 + ai * HALF + m * 16]);
#pragma unroll
        for (int ai = 0; ai < 2; ++ai)
#pragma unroll
            for (int m = 0; m < 4; ++m) { const unsigned row = (unsigned)(row0 + ai * HALF + m * 16); const float s1 = rs8[ai][m]; unsigned pc[2][2];
#pragma unroll
                for (int bj = 0; bj < 2; ++bj) { f32x4 v0 = __builtin_convertvector(__builtin_bit_cast(i4_, acc[ai][bj][m][0]), f32x4) * s1, v1 = __builtin_convertvector(__builtin_bit_cast(i4_, acc[ai][bj][m][1]), f32x4) * s1;
                    const float qm1 = HID_U8 ? 15.968719f : 11.269427f;
#pragma unroll
                    for (int e_ = 0; e_ < 4; ++e_) { const float t0 = __builtin_amdgcn_fmed3f(v0[e_], 0.f, qm1), t1 = __builtin_amdgcn_fmed3f(v1[e_], 0.f, qm1); v0[e_] = t0; v1[e_] = t1; }
                    v0 = v0 * v0 + 12582912.f; v1 = v1 * v1 + 12582912.f;
                    const u32x4 b0 = __builtin_bit_cast(u32x4, v0), b1 = __builtin_bit_cast(u32x4, v1);
                    pc[bj][0] = __builtin_amdgcn_perm(b0.y, b0.x, 0x0c0c0400u) | __builtin_amdgcn_perm(b0.w, b0.z, 0x04000c0cu);
                    pc[bj][1] = __builtin_amdgcn_perm(b1.y, b1.x, 0x0c0c0400u) | __builtin_amdgcn_perm(b1.w, b1.z, 0x04000c0cu);
                    if (HID_U8) { pc[bj][0] ^= 0x80808080u; pc[bj][1] ^= 0x80808080u; } }
                unsigned a0 = pc[0][0], b0_ = pc[1][0], a1 = pc[0][1], b1_ = pc[1][1];
                asm volatile("s_nop 1\n\tv_permlane16_swap_b32 %0, %1\n\tv_permlane16_swap_b32 %2, %3\n\ts_nop 1" : "+v"(a0), "+v"(b0_), "+v"(a1), "+v"(b1_));
                u32x4 w; w.x = a0; w.y = a1; w.z = b0_; w.w = b1_;
                const unsigned unit = (odd ? 2u : 0u) + (unsigned)(fq >> 1);
                __builtin_amdgcn_raw_buffer_store_b128(w, rsrc, ((row >> 4) * (unsigned)(kbytes >> 6) + blkcol) * 1024u + (unsigned)fr * 64u + unit * 16u, 0, 2); }
    }
};
typedef unsigned u32x2_ __attribute__((ext_vector_type(2)));
template <bool I8R = false> struct EpiRopeT {
    static constexpr bool PERM = true, AFTER_DRAIN = false;
    bf16_t* O; int ldc; const int* pos; const float* tab; float qscale; int cbase = 0; const float* rinv = nullptr; const float* winv = nullptr; unsigned char* k8 = nullptr;
    __device__ __forceinline__ void operator()(const f32x4 (&acc)[2][2][4][2], const Unit& u, int wr, int wc, int fr_in, int fq_in) const {
        int fr = fr_in, fq = fq_in; asm volatile("" : "+v"(fr), "+v"(fq));
        const int row0 = u.pm * BM + wr * 64 + fr; const int col0 = cbase + u.pn * BM + wc * 64 + 8 * fq;
        float ih[2][4], il[2][4]; int kind[2]; float sc[2];
#pragma unroll
        for (int bj = 0; bj < 2; ++bj) { const int cb = col0 + bj * 32; int k = 0, i0 = 0; sc[bj] = 1.f;
            if (cb < 2176) { k = 1; i0 = (cb & 127) >> 1; if (cb < 2048) sc[bj] = qscale; }
            else if (cb >= 2304 && cb < 3392) { k = 2; i0 = 64 + ((cb & 63) >> 1); }
            kind[bj] = k;
#pragma unroll
            for (int p = 0; p < 4; ++p) { ih[bj][p] = k ? tab[2 * (i0 + p)] : 0.f; il[bj][p] = k ? tab[2 * (i0 + p) + 1] : 0.f; } }
        float pf8[2][4];
#pragma unroll
        for (int ai = 0; ai < 2; ++ai)
#pragma unroll
            for (int m = 0; m < 4; ++m) pf8[ai][m] = (float)pos[row0 + ai * HALF + m * 16];
        float rq8[2][4];
        if (I8R) { const float wi = winv[0];
#pragma unroll
            for (int ai = 0; ai < 2; ++ai)
#pragma unroll
                for (int m = 0; m < 4; ++m) rq8[ai][m] = rinv[row0 + ai * HALF + m * 16] * wi; }
#pragma unroll
        for (int ai = 0; ai < 2; ++ai)
#pragma unroll
            for (int m = 0; m < 4; ++m) { const int row = row0 + ai * HALF + m * 16; const float pf = pf8[ai][m]; u32x4 wq[2];
#pragma unroll
                for (int bj = 0; bj < 2; ++bj) { f32x4 v0 = acc[ai][bj][m][0], v1 = acc[ai][bj][m][1];
                    if (I8R) { typedef int i4_ __attribute__((ext_vector_type(4)));
                        v0 = __builtin_convertvector(__builtin_bit_cast(i4_, v0), f32x4) * rq8[ai][m]; v1 = __builtin_convertvector(__builtin_bit_cast(i4_, v1), f32x4) * rq8[ai][m]; }
                    if (kind[bj]) { float x[8] = {v0[0], v0[1], v0[2], v0[3], v1[0], v1[1], v1[2], v1[3]};
#pragma unroll
                        for (int p = 0; p < 4; ++p) { const float rh = pf * ih[bj][p]; const float e = __builtin_fmaf(pf, ih[bj][p], -rh) + pf * il[bj][p];
                            const float frc = (rh - __builtin_floorf(rh)) + e; const float sn = __builtin_amdgcn_sinf(frc), cs = __builtin_amdgcn_cosf(frc);
                            const float a = x[2 * p], b = x[2 * p + 1]; x[2 * p] = (a * cs - b * sn) * sc[bj]; x[2 * p + 1] = (b * cs + a * sn) * sc[bj]; }
                        v0 = (f32x4){x[0], x[1], x[2], x[3]}; v1 = (f32x4){x[4], x[5], x[6], x[7]}; }
                    wq[bj].x = cvt_pk_bf16(v0[0], v0[1]); wq[bj].y = cvt_pk_bf16(v0[2], v0[3]); wq[bj].z = cvt_pk_bf16(v1[0], v1[1]); wq[bj].w = cvt_pk_bf16(v1[2], v1[3]);
                    if (I8R && DSA_K8) { const int cb = col0 + bj * 32; if (k8 != nullptr && cb >= 2048 && cb < 2176) { float sq_ = 0.f; u32x2_ w8;
                            w8.x = pk_i8x4s(v0[0], v0[1], v0[2], v0[3], 127.f / 6.f, sq_); w8.y = pk_i8x4s(v1[0], v1[1], v1[2], v1[3], 127.f / 6.f, sq_);
                            *(u32x2_*)(k8 + (size_t)row * 128 + (cb - 2048)) = w8; } } }
                store_rowpair(O, ldc, row, col0, (fr & 1) != 0, wq[0], wq[1]); }
    }
};
typedef EpiRopeT<false> EpiRope;
typedef int i32x4_ __attribute__((ext_vector_type(4)));
template <class Epi, class Sched, bool ALIGN_EPI = false, bool SP2 = false, bool A_BLK = false, bool F8 = false, bool I8 = false>
__device__ __forceinline__ void gemm_phase(PG8_LAS unsigned char* lds, const Gemm g, const Sched& S, const Epi& E) {
    int tid = threadIdx.x; asm volatile("" : "+v"(tid));
    const int wid = __builtin_amdgcn_readfirstlane(tid >> 6), lane = tid & 63, wr = wid >> 2, wc = wid & 3, fr = lane & 15, fq = lane >> 4;
    const int K = g.K, nt = K / BK;
    unsigned voffA[2], voffB[2];
#pragma unroll
    for (int i = 0; i < 2; ++i) { int R, C; stage_rc(tid * 16 + i * 8192, R, C); const int Rb = Epi::PERM ? (64 * (R >> 5) + perm32(R & 31)) : R;
        voffA[i] = A_BLK ? (unsigned)(((R >> 4) * (K >> 5) + (C >> 5)) * 1024 + (R & 15) * 64 + (C & 31) * 2) : (unsigned)(R * K + C) * 2u; voffB[i] = (unsigned)(Rb * K + C) * 2u; }
    const size_t kstep = (size_t)(BK * 2);
    const size_t kstepA = A_BLK ? (size_t)2048 : kstep;
    const size_t hstep = (size_t)HALF * K * 2;
    const size_t hstepB = (size_t)32 * K * 2;
    const size_t tstep = 2 * hstep;
    const unsigned ldsw = (unsigned)wid * 1024u;
    const int aoff = lds_byte(wr * 64 + fr, fq * 8), boff = lds_byte(wc * 32 + fr, fq * 8);
#define PG8_SA(b, h) (((b) * 2 + (h)) * HTB)
#define PG8_SB(b, h) ((4 + (b) * 2 + (h)) * HTB)
#define PG8_STAGE(bufoff, gbase, voff) do { _Pragma("unroll") for (int _i = 0; _i < 2; ++_i) \
        __builtin_amdgcn_global_load_lds((const unsigned*)((const char*)(gbase) + (voff)[_i]), (PG8_LAS unsigned*)(lds + (bufoff) + ldsw + _i * 8192), 16, 0, 0); } while (0)
#define PG8_LDA(dst, b, h) do { if constexpr (F8) { _Pragma("unroll") for (int m = 0; m < 4; ++m) dst##8[m] = cat8(*(const PG8_LAS bf16x8*)(lds + PG8_SA(b, h) + aoff + m * 2048), *(const PG8_LAS bf16x8*)(lds + PG8_SA(b, h) + aoff + m * 2048 + 1024)); } \
        else { _Pragma("unroll") for (int m = 0; m < 4; ++m) _Pragma("unroll") for (int k = 0; k < 2; ++k) dst[m][k] = *(const PG8_LAS bf16x8*)(lds + PG8_SA(b, h) + aoff + m * 2048 + k * 1024); } } while (0)
#define PG8_LDB(dst, b, h) do { if constexpr (F8) { _Pragma("unroll") for (int n = 0; n < 2; ++n) dst##8[n] = cat8(*(const PG8_LAS bf16x8*)(lds + PG8_SB(b, h) + boff + n * 2048), *(const PG8_LAS bf16x8*)(lds + PG8_SB(b, h) + boff + n * 2048 + 1024)); } \
        else { _Pragma("unroll") for (int n = 0; n < 2; ++n) _Pragma("unroll") for (int k = 0; k < 2; ++k) dst[n][k] = *(const PG8_LAS bf16x8*)(lds + PG8_SB(b, h) + boff + n * 2048 + k * 1024); } } while (0)
#define PG8_MMA(ai, bj, At, Bt) do { __builtin_amdgcn_s_setprio(1); \
        if constexpr (F8) { _Pragma("unroll") for (int m = 0; m < 4; ++m) _Pragma("unroll") for (int n = 0; n < 2; ++n) acc[ai][bj][m][n] = __builtin_amdgcn_mfma_scale_f32_16x16x128_f8f6f4(Bt##8[n], At##8[m], acc[ai][bj][m][n], 0, 0, 0, 0, 0, 0); } \
        else if constexpr (I8) { _Pragma("unroll") for (int m = 0; m < 4; ++m) _Pragma("unroll") for (int n = 0; n < 2; ++n) _Pragma("unroll") for (int k = 0; k < 2; ++k) \
        acc[ai][bj][m][n] = __builtin_bit_cast(f32x4, __builtin_amdgcn_mfma_i32_16x16x64_i8(__builtin_bit_cast(i32x4_, Bt[n][k]), __builtin_bit_cast(i32x4_, At[m][k]), __builtin_bit_cast(i32x4_, acc[ai][bj][m][n]), 0, 0, 0)); } \
        else { _Pragma("unroll") for (int m = 0; m < 4; ++m) _Pragma("unroll") for (int n = 0; n < 2; ++n) _Pragma("unroll") for (int k = 0; k < 2; ++k) \
        acc[ai][bj][m][n] = __builtin_amdgcn_mfma_f32_16x16x32_f16(__builtin_bit_cast(h16x8, Bt[n][k]), __builtin_bit_cast(h16x8, At[m][k]), acc[ai][bj][m][n], 0, 0, 0); } __builtin_amdgcn_s_setprio(0); } while (0)
#define PG8_WAIT_V(n) asm volatile("s_waitcnt vmcnt(" #n ")" ::: "memory")
#define PG8_WAIT_L(n) asm volatile("s_waitcnt lgkmcnt(" #n ")" ::: "memory")
#define PG8_BAR __builtin_amdgcn_s_barrier()
#define PG8_SCHED __builtin_amdgcn_sched_barrier(0)
    Unit cur, nxt; int ui = 0;
    if (!S.next(0, cur)) return;
    f32x4 acc[2][2][4][2];
#pragma unroll
    for (int a = 0; a < 2; ++a)
#pragma unroll
        for (int b = 0; b < 2; ++b)
#pragma unroll
            for (int m = 0; m < 4; ++m)
#pragma unroll
                for (int n = 0; n < 2; ++n) acc[a][b][m][n] = (f32x4){0.f, 0.f, 0.f, 0.f};
    bf16x8 At[4][2], B0[2][2], B1[2][2]; i32x8 At8[4], B08[2], B18[2];
    const char* cA = (const char*)g.A + (size_t)cur.pm * tstep; const char* cB = (const char*)g.Bt + (size_t)cur.pn * tstep;
    S.a_ready(cur);
    if constexpr (SP2) {
        PG8_STAGE(PG8_SB(0, 0), cB, voffB); PG8_STAGE(PG8_SB(0, 1), cB + hstepB, voffB); PG8_STAGE(PG8_SA(0, 0), cA, voffA); PG8_STAGE(PG8_SA(0, 1), cA + hstep, voffA);
        if (wr == 1) PG8_BAR;
        PG8_WAIT_V(2); PG8_BAR;
        PG8_STAGE(PG8_SB(1, 0), cB + kstep, voffB); PG8_STAGE(PG8_SA(1, 0), cA + kstepA, voffA); PG8_STAGE(PG8_SB(1, 1), cB + hstepB + kstep, voffB);
        PG8_WAIT_V(6); PG8_BAR;
    } else {
        PG8_STAGE(PG8_SB(0, 0), cB, voffB); PG8_STAGE(PG8_SA(0, 0), cA, voffA); PG8_STAGE(PG8_SB(0, 1), cB + hstepB, voffB); PG8_STAGE(PG8_SA(0, 1), cA + hstep, voffA);
        if (wr == 1) PG8_BAR;
        PG8_WAIT_V(4); PG8_BAR;
        PG8_STAGE(PG8_SB(1, 0), cB + kstep, voffB); PG8_STAGE(PG8_SA(1, 0), cA + kstepA, voffA); PG8_STAGE(PG8_SB(1, 1), cB + hstepB + kstep, voffB);
        PG8_WAIT_V(6); PG8_BAR;
    }
    for (;;) {
        const bool has_next = S.next(ui + 1, nxt);
        const char* nA = has_next ? (const char*)g.A + (size_t)nxt.pm * tstep : cA; const char* nB = has_next ? (const char*)g.Bt + (size_t)nxt.pn * tstep : cB;
        for (int t = 0; t < nt; t += 2) {
            const bool last = (t == nt - 2);
            const char* a1 = cA + (size_t)(t + 1) * kstepA;
            const char* a2 = last ? nA : cA + (size_t)(t + 2) * kstepA; const char* b2 = last ? nB : cB + (size_t)(t + 2) * kstep;
            const char* a3 = a2 + kstepA; const char* b3 = b2 + kstep;
            if (last && has_next) S.a_ready(nxt);
            if constexpr (SP2) {
            PG8_LDB(B0, 0, 0); PG8_LDB(B1, 0, 1); PG8_SCHED; PG8_LDA(At, 0, 0); PG8_STAGE(PG8_SA(1, 1), a1 + hstep, voffA);
            PG8_WAIT_V(8); PG8_WAIT_L(0); PG8_BAR; PG8_MMA(0, 0, At, B0); PG8_MMA(0, 1, At, B1); PG8_BAR; PG8_SCHED;
            PG8_LDA(At, 0, 1); PG8_STAGE(PG8_SB(0, 0), b2, voffB); PG8_STAGE(PG8_SB(0, 1), b2 + hstepB, voffB); PG8_STAGE(PG8_SA(0, 0), a2, voffA);
            PG8_WAIT_V(8); PG8_WAIT_L(0); PG8_BAR; PG8_MMA(1, 0, At, B0); PG8_MMA(1, 1, At, B1); PG8_BAR; PG8_SCHED;
            PG8_LDB(B0, 1, 0); PG8_LDB(B1, 1, 1); PG8_SCHED; PG8_LDA(At, 1, 0); PG8_STAGE(PG8_SA(0, 1), a2 + hstep, voffA);
            PG8_WAIT_V(8); PG8_WAIT_L(0); PG8_BAR; PG8_MMA(0, 0, At, B0); PG8_MMA(0, 1, At, B1); PG8_BAR; PG8_SCHED;
            PG8_LDA(At, 1, 1); PG8_STAGE(PG8_SB(1, 0), b3, voffB); PG8_STAGE(PG8_SB(1, 1), b3 + hstepB, voffB); PG8_STAGE(PG8_SA(1, 0), a3, voffA);
            PG8_WAIT_V(8); PG8_WAIT_L(0); PG8_BAR; PG8_MMA(1, 0, At, B0); PG8_MMA(1, 1, At, B1); PG8_BAR; PG8_SCHED;
            } else {
            PG8_LDB(B0, 0, 0); PG8_SCHED; PG8_LDA(At, 0, 0); PG8_STAGE(PG8_SA(1, 1), a1 + hstep, voffA);
            PG8_WAIT_L(8); PG8_BAR; PG8_WAIT_L(0); PG8_MMA(0, 0, At, B0); PG8_BAR; PG8_SCHED;
            PG8_LDB(B1, 0, 1); PG8_STAGE(PG8_SB(0, 0), b2, voffB);
            PG8_BAR; PG8_WAIT_L(0); PG8_MMA(0, 1, At, B1); PG8_BAR;
            PG8_LDA(At, 0, 1); PG8_STAGE(PG8_SA(0, 0), a2, voffA);
            PG8_BAR; PG8_WAIT_L(0); PG8_MMA(1, 0, At, B0); PG8_BAR; PG8_SCHED;
            PG8_STAGE(PG8_SB(0, 1), b2 + hstepB, voffB);
            PG8_WAIT_V(6); PG8_BAR; PG8_MMA(1, 1, At, B1); PG8_BAR;
            PG8_LDB(B0, 1, 0); PG8_SCHED; PG8_LDA(At, 1, 0); PG8_STAGE(PG8_SA(0, 1), a2 + hstep, voffA);
            PG8_WAIT_L(8); PG8_BAR; PG8_WAIT_L(0); PG8_MMA(0, 0, At, B0); PG8_BAR; PG8_SCHED;
            PG8_LDB(B1, 1, 1); PG8_STAGE(PG8_SB(1, 0), b3, voffB);
            PG8_BAR; PG8_WAIT_L(0); PG8_MMA(0, 1, At, B1); PG8_BAR;
            PG8_LDA(At, 1, 1); PG8_STAGE(PG8_SA(1, 0), a3, voffA);
            PG8_BAR; PG8_WAIT_L(0); PG8_MMA(1, 0, At, B0); PG8_BAR; PG8_SCHED;
            PG8_STAGE(PG8_SB(1, 1), b3 + hstepB, voffB);
            PG8_WAIT_V(6); PG8_BAR; PG8_MMA(1, 1, At, B1); PG8_BAR;
            }
        }
        if constexpr (ALIGN_EPI) { if (wr == 0) PG8_BAR; }
        if constexpr (!Epi::AFTER_DRAIN) { E(acc, cur, wr, wc, fr, fq); S.done(cur); }
        if (!has_next) break;
#pragma unroll
        for (int a = 0; a < 2; ++a)
#pragma unroll
            for (int b = 0; b < 2; ++b)
#pragma unroll
                for (int m = 0; m < 4; ++m)
#pragma unroll
                    for (int n = 0; n < 2; ++n) acc[a][b][m][n] = (f32x4){0.f, 0.f, 0.f, 0.f};
        cur = nxt; cA = nA; cB = nB; ++ui;
        if constexpr (ALIGN_EPI) { if (wr == 1) PG8_BAR; }
    }
    PG8_WAIT_V(0);
    if constexpr (!ALIGN_EPI) { if (wr == 0) PG8_BAR; }
    PG8_BAR;
    if constexpr (Epi::AFTER_DRAIN) { E.fused(acc, cur, wr, wc, fr, fq, lds, wid, lane); S.done(cur); }
#undef PG8_SA
#undef PG8_SB
#undef PG8_STAGE
#undef PG8_LDA
#undef PG8_LDB
#undef PG8_MMA
#undef PG8_WAIT_V
#undef PG8_WAIT_L
#undef PG8_BAR
#undef PG8_SCHED
}
}
namespace att {
typedef _Float16 h16x8 __attribute__((ext_vector_type(8)));
typedef short s16x8_ __attribute__((ext_vector_type(8))); typedef float f32x16_ __attribute__((ext_vector_type(16)));
__device__ __forceinline__ f32x16_ MFMA32_H(s16x8_ a, s16x8_ b, f32x16_ c, int, int, int) { return __builtin_amdgcn_mfma_f32_32x32x16_f16(__builtin_bit_cast(h16x8, a), __builtin_bit_cast(h16x8, b), c, 0, 0, 0); }
enum { ORDER_NATURAL = 0, ORDER_REVERSED = 1, ORDER_PAIRED = 2, ORDER_XCD = 4 };
using TIN = __hip_bfloat16; using TOUT = __hip_bfloat16;
constexpr int SQ = 4096, SKV = 4096, D = 128, QOFF = 0, WINDOW = SKV;
constexpr int LDQ = 6144, LDO = 2048;
#define BOFF(r, c) ((size_t)((((r) >> 4) * (LDQ / 32) + ((c) >> 5)) * 512 + ((r) & 15) * 32 + ((c) & 31)))
#define ST_ROW(tid) (16 * ((tid) >> 8) + (((tid) & 63) >> 2))
#define ST_COL(tid) ((4 * (((tid) >> 6) & 3) + ((tid) & 3)) * 8)
constexpr float THR = 8.f;
constexpr bool WSKIP = false;
constexpr float SCALE = 0.08838834764831845f;
constexpr int NW = 8, QBLK = 32, KVBLK = 64, QB = NW * QBLK;
constexpr int SHM_V = KVBLK * D * 2, SHM_K = KVBLK * D * 2;
constexpr int LDS_TILES = 2 * SHM_V + 2 * SHM_K + NW * 64 * 4;
constexpr int LDS_FB = LDS_TILES;
constexpr int LDS_BYTES = LDS_FB + SKV * 4 + 256;
constexpr int LDS_SB_BYTES = 2 * SHM_V + 2 * SHM_K + NW * QBLK * 256;
using bf16 = __hip_bfloat16;
typedef short bf16x8 __attribute__((ext_vector_type(8)));
typedef short s16x4 __attribute__((ext_vector_type(4)));
typedef float f32x16 __attribute__((ext_vector_type(16)));
typedef float f32x4 __attribute__((ext_vector_type(4)));
typedef unsigned u32x4 __attribute__((ext_vector_type(4)));
template <class A, class Bt> struct same_t { static constexpr bool v = false; };
template <class A> struct same_t<A, A> { static constexpr bool v = true; };

#define KSWZ(row, colB) ((row) * 256 + ((colB) ^ (((row) & 7) << 4)))
#define SBAR() __builtin_amdgcn_sched_barrier(0)
__device__ __forceinline__ int v_st(int k, int c) { const int kk = (k & ~0xC) | ((k & 4) << 1) | ((k & 8) >> 1); return ((kk >> 3) * 4 + (c >> 5)) * 512 + ((kk & 7) * 32 + (c & 31)) * 2; }
__device__ __forceinline__ int v_rd_base(int lane) { return ((lane & 3) << 3) | (((lane >> 2) & 3) << 6) | (((lane >> 4) & 1) << 5) | (((lane >> 5) & 1) << 8); }
constexpr int v_rd_off(int d0, int ks, int half) { return d0 * 512 + ks * 4096 + half * 2048; }
__device__ __forceinline__ int crow(int r, int hi) { return (r & 3) + 8 * (r >> 2) + 4 * hi; }
__device__ __forceinline__ unsigned cvtpk(float lo, float hi) {
    unsigned r; asm volatile("v_cvt_pk_f16_f32 %0, %1, %2" : "=v"(r) : "v"(lo), "v"(hi)); return r;
}
__device__ __forceinline__ bf16x8 pack8(f32x4 a, f32x4 b) {
    u32x4 w = {cvtpk(a[0], a[1]), cvtpk(a[2], a[3]), cvtpk(b[0], b[1]), cvtpk(b[2], b[3])};
    return *reinterpret_cast<bf16x8*>(&w);
}
template <class T> __device__ __forceinline__ bf16x8 load8(const T* p) {
    if constexpr (same_t<T, float>::v) { return pack8(*(const f32x4*)p, *(const f32x4*)(p + 4)); }
    else { return *reinterpret_cast<const bf16x8*>(p); }
}
__device__ __forceinline__ void mask_tile(f32x16& p0, f32x16& p1, int dq, unsigned W) {
    const float NEG = -__builtin_inff();
#pragma unroll
    for (int r = 0; r < 16; ++r) {
        const int c = (r & 3) + 8 * (r >> 2);
        if ((unsigned)(dq - c) >= W) p0[r] = NEG;
        if ((unsigned)(dq - c - 32) >= W) p1[r] = NEG;
    }
}
__device__ __forceinline__ void partialSM(f32x16& p0, f32x16& p1, float& m_reg, float& mn, float& alpha) {
    float pmax = p0[0]; for (int r = 1; r < 16; ++r) pmax = fmaxf(pmax, p0[r]); for (int r = 0; r < 16; ++r) pmax = fmaxf(pmax, p1[r]);
    { auto rr = __builtin_amdgcn_permlane32_swap(__float_as_uint(pmax), __float_as_uint(pmax), false, false);
      pmax = fmaxf(__uint_as_float(rr[0]), __uint_as_float(rr[1])); }
    constexpr float C2 = 1.4426950408889634f * SCALE;
    if (__builtin_expect(__all((pmax - m_reg) * SCALE <= THR), 1)) { mn = m_reg; alpha = 1.f; }
    else { mn = fmaxf(m_reg, pmax); alpha = __builtin_amdgcn_exp2f((m_reg - mn) * C2); m_reg = mn; }
    const float mnL = -mn * C2;
    for (int r = 0; r < 16; ++r) p0[r] = fmaf(p0[r], C2, mnL); for (int r = 0; r < 16; ++r) p1[r] = fmaf(p1[r], C2, mnL);
    for (int r = 0; r < 16; ++r) p0[r] = __builtin_amdgcn_exp2f(p0[r]);
}
__device__ __forceinline__ void finishSM(f32x16& p0, f32x16& p1, float alpha, float& l_reg, bf16x8& pa0, bf16x8& pa1, bf16x8& pa2, bf16x8& pa3) {
    for (int r = 0; r < 16; ++r) p1[r] = __builtin_amdgcn_exp2f(p1[r]);
    float ps = 0; for (int r = 0; r < 16; ++r) ps += p0[r]; for (int r = 0; r < 16; ++r) ps += p1[r];
    { auto rr = __builtin_amdgcn_permlane32_swap(__float_as_uint(ps), __float_as_uint(ps), false, false);
      ps = __uint_as_float(rr[0]) + __uint_as_float(rr[1]); }
    l_reg = l_reg * alpha + ps;
#define PK4(P, B_, OUT) do { unsigned a0 = cvtpk(P[B_+0], P[B_+1]), a1 = cvtpk(P[B_+2], P[B_+3]);                          \
        unsigned b0 = cvtpk(P[B_+4], P[B_+5]), b1 = cvtpk(P[B_+6], P[B_+7]);                                             \
        auto r0 = __builtin_amdgcn_permlane32_swap(a0, b0, false, false); auto r1 = __builtin_amdgcn_permlane32_swap(a1, b1, false, false); \
        u32x4 w = {r0[0], r1[0], r0[1], r1[1]}; OUT = *reinterpret_cast<bf16x8*>(&w); } while (0)
    PK4(p0, 0, pa0); PK4(p0, 8, pa1); PK4(p1, 0, pa2); PK4(p1, 8, pa3);
#undef PK4
}
template <int KB, bool SK, bool BIAS>
__device__ __forceinline__ void qkt(f32x16& p0, f32x16& p1, const char* K_lds, int r32, int hi, const bf16x8* qr, bool act, unsigned fbt) {
    if (SK && !act) { const float NEG = -__builtin_inff();
#pragma unroll
        for (int r = 0; r < 16; ++r) { p0[r] = NEG; p1[r] = NEG; } return; }
    if constexpr (BIAS) { typedef __attribute__((address_space(3))) const f32x4* lp4; const lp4 f4 = (lp4)fbt;
#pragma unroll
        for (int g = 0; g < 4; ++g) { const f32x4 a = f4[2 * g], b = f4[8 + 2 * g];
            p0[4 * g] = a[0]; p0[4 * g + 1] = a[1]; p0[4 * g + 2] = a[2]; p0[4 * g + 3] = a[3];
            p1[4 * g] = b[0]; p1[4 * g + 1] = b[1]; p1[4 * g + 2] = b[2]; p1[4 * g + 3] = b[3]; } }
    else { p0 = f32x16{}; p1 = f32x16{}; }
    const char* kb[4];
#pragma unroll
    for (int dd = 0; dd < 4; ++dd) kb[dd] = K_lds + KB * SHM_K + KSWZ(r32, (dd * 16 + hi * 8) * 2);
#pragma unroll
    for (int d0 = 0; d0 < 8; ++d0) { const char* a = kb[d0 & 3] + (d0 >> 2) * 128;
        bf16x8 b0 = *reinterpret_cast<const bf16x8*>(a);
        bf16x8 b1 = *reinterpret_cast<const bf16x8*>(a + 32 * 256);
        p0 = MFMA32_H(b0, qr[d0], p0, 0, 0, 0);
        p1 = MFMA32_H(b1, qr[d0], p1, 0, 0, 0); }
}
template <int VB, bool SK>
__device__ __forceinline__ void pv_tile(f32x16* o, int vb0, bf16x8 pa0, bf16x8 pa1, bf16x8 pa2, bf16x8 pa3, bool act) {
    if (SK && !act) return;
#define TRRD(dst, off) asm volatile("ds_read_b64_tr_b16 %0, %1 offset:%2" : "=&v"(dst) : "v"(vb0), "i"(off) : "memory")
#define PV_D0(d0) do { s16x4 l0, l1, l2, l3, h0, h1, h2, h3; constexpr int b_ = VB * SHM_V + v_rd_off(d0, 0, 0);     \
        TRRD(l0, b_); TRRD(h0, b_ + 2048); TRRD(l1, b_ + 4096); TRRD(h1, b_ + 6144); TRRD(l2, b_ + 8192); TRRD(h2, b_ + 10240); TRRD(l3, b_ + 12288); TRRD(h3, b_ + 14336); \
        asm volatile("s_waitcnt lgkmcnt(0)" ::: "memory"); SBAR();                 \
        o[d0] = MFMA32_H(pa0, (bf16x8){l0[0], l0[1], l0[2], l0[3], h0[0], h0[1], h0[2], h0[3]}, o[d0], 0, 0, 0);   \
        o[d0] = MFMA32_H(pa1, (bf16x8){l1[0], l1[1], l1[2], l1[3], h1[0], h1[1], h1[2], h1[3]}, o[d0], 0, 0, 0);   \
        o[d0] = MFMA32_H(pa2, (bf16x8){l2[0], l2[1], l2[2], l2[3], h2[0], h2[1], h2[2], h2[3]}, o[d0], 0, 0, 0);   \
        o[d0] = MFMA32_H(pa3, (bf16x8){l3[0], l3[1], l3[2], l3[3], h3[0], h3[1], h3[2], h3[3]}, o[d0], 0, 0, 0); } while (0)
    PV_D0(0); PV_D0(1); PV_D0(2); PV_D0(3);
#undef PV_D0
#undef TRRD
}

template <class TIn, class TOut> struct BlockRef { const TIn* Q; const TIn* K; const TIn* V; TOut* O; int P0; };
template <class TIn> struct Seam {
    bf16x8 qr[8];
    bf16x8 st_v0, st_v1, st_k0, st_k1; f32x4 sf0, sf1, sf2, sf3;
    f32x4 tq[16];
};
__device__ __forceinline__ int swa_jlo(int P0, int W) { const int lowk = P0 - W + 1; return lowk > 0 ? lowk / KVBLK : 0; }
#define ROW(p, k0, rr) ((p) + BOFF((k0) + (rr), sc))
#define VMW() asm volatile("s_waitcnt vmcnt(0)" ::: "memory")
#define VMWN(n) asm volatile("s_waitcnt vmcnt(%0)" :: "i"(n) : "memory")
#define SLOAD_H(Kp, Vp, k0) do { S.st_v0 = load8<TIn>(ROW(Vp, k0, sr)); S.st_v1 = load8<TIn>(ROW(Vp, k0, 32 + sr));              \
                         S.st_k0 = load8<TIn>(ROW(Kp, k0, sr)); S.st_k1 = load8<TIn>(ROW(Kp, k0, 32 + sr)); } while (0)
#define SWRITE_HK(bf) do { *(bf16x8*)(K_lds + (bf) * SHM_K + kws) = S.st_k0; *(bf16x8*)(K_lds + (bf) * SHM_K + kws + 32 * 256) = S.st_k1; } while (0)
#define SWRITE_HV(bf) do { *(bf16x8*)(V_lds + (bf) * SHM_V + vst0) = S.st_v0; *(bf16x8*)(V_lds + (bf) * SHM_V + vst1) = S.st_v1; } while (0)
#define SWRITE_H(bf) do { SWRITE_HV(bf); SWRITE_HK(bf); } while (0)
#define SLOAD_F(p, k0) do { S.sf0 = *(const f32x4*)ROW(p, k0, sr); S.sf1 = *(const f32x4*)(ROW(p, k0, sr) + 4);                \
                            S.sf2 = *(const f32x4*)ROW(p, k0, 32 + sr); S.sf3 = *(const f32x4*)(ROW(p, k0, 32 + sr) + 4); } while (0)
#define SWRITE_KF(bf) do { *(bf16x8*)(K_lds + (bf) * SHM_K + kws) = pack8(S.sf0, S.sf1); *(bf16x8*)(K_lds + (bf) * SHM_K + kws + 32 * 256) = pack8(S.sf2, S.sf3); } while (0)
#define SWRITE_VF(bf) do { *(bf16x8*)(V_lds + (bf) * SHM_V + vst0) = pack8(S.sf0, S.sf1); *(bf16x8*)(V_lds + (bf) * SHM_V + vst1) = pack8(S.sf2, S.sf3); } while (0)
template <class TIn, class TOut>
__device__ __forceinline__ void causal_swa_prime(const BlockRef<TIn, TOut>& cur, int W, char* lds, Seam<TIn>& S) {
    constexpr bool F32 = same_t<TIn, float>::v;
    int tid = threadIdx.x; asm volatile("" : "+v"(tid)); const int wid = __builtin_amdgcn_readfirstlane(tid >> 6), lane = tid & 63, r32 = lane & 31, hi = lane >> 5;
    const int sr = ST_ROW(tid), sc = ST_COL(tid), kws = KSWZ(sr, sc * 2); char* K_lds = lds + 2 * SHM_V;
    const int kb0 = swa_jlo(cur.P0, W) * KVBLK;
    for (int d0 = 0; d0 < 8; ++d0) S.qr[d0] = load8<TIn>(cur.Q + BOFF(wid * QBLK + r32, d0 * 16 + hi * 8));
    if constexpr (F32) { SLOAD_F((const float*)cur.K, kb0); VMW(); SWRITE_KF(0); SBAR(); SLOAD_F((const float*)cur.V, kb0); }
    else { SLOAD_H(cur.K, cur.V, kb0); VMW(); SWRITE_HK(0); }
    __syncthreads();
}
template <class TIn, class TOut, bool FB = true>
__device__ __forceinline__ void causal_swa_block(const BlockRef<TIn, TOut>& cur, const BlockRef<TIn, TOut>& nxt, int skv, int W, char* lds, Seam<TIn>& S, unsigned fb) {
    constexpr bool F32 = same_t<TIn, float>::v;
    int tid = threadIdx.x; asm volatile("" : "+v"(tid)); const int wid = __builtin_amdgcn_readfirstlane(tid >> 6), lane = tid & 63, r32 = lane & 31, hi = lane >> 5;
    const int j_lo = swa_jlo(cur.P0, W);
    int j_hi = (cur.P0 + QB - 1) / KVBLK + 1; if (j_hi > skv / KVBLK) j_hi = skv / KVBLK;
    const int NT = j_hi - j_lo;
    const int kbn = swa_jlo(nxt.P0, W) * KVBLK;
    const int qlo = cur.P0 + wid * QBLK, qm = qlo + r32 - 4 * hi;
    char* V_lds = lds; char* K_lds = lds + 2 * SHM_V;
    float* ws = (float*)(lds + 2 * SHM_V + 2 * SHM_K) + wid * 64; float* li_l = ws, * al_l = ws + 32;
    float m_reg = -1e30f, l_reg = 0; f32x16 o[4] = {};
    const int sr = ST_ROW(tid), sc = ST_COL(tid), vst0 = v_st(sr, sc), vst1 = v_st(32 + sr, sc), kws = KSWZ(sr, sc * 2);
    const int vb0 = (int)(uintptr_t)V_lds + v_rd_base(lane);
    const TIn* Kh = cur.K; const TIn* Vh = cur.V;
#define RESC(a) do { if (__any((a) < 1.f)) { if (hi == 0) al_l[r32] = (a); asm volatile("s_waitcnt lgkmcnt(0)" ::: "memory");              \
                     for (int d_ = 0; d_ < 4; ++d_) for (int r = 0; r < 16; ++r) o[d_][r] *= al_l[crow(r, hi)]; } } while (0)
#define KBASE(t) ((j_lo + (t)) * KVBLK)
#define ACT(t) (KBASE(t) <= qlo + QBLK - 1 && KBASE(t) + KVBLK - 1 >= qlo - W + 1)
#define MASKT(P0_, P1_, t) do { const int kb_ = KBASE(t); if ((!SK || ACT(t)) && (kb_ + KVBLK - 1 > qlo || kb_ <= qlo + QBLK - 1 - W)) mask_tile(P0_, P1_, qm - kb_, (unsigned)W); } while (0)
    constexpr int NQL = F32 ? 16 : 8;
    constexpr bool SK = WSKIP && !F32;
#define SEAM_K0() do { VMWN(NQL); if constexpr (F32) { SWRITE_KF(0); SBAR(); SLOAD_F((const float*)nxt.V, kbn); } else { SWRITE_HK(0); } SBAR(); } while (0)
    f32x16 pA0, pA1, pB0, pB1; float mnA, mnB, alA, alB; bf16x8 pa0, pa1, pa2, pa3;
    if constexpr (F32) { VMW(); SWRITE_VF(0); SBAR(); } else { SWRITE_HV(0); SBAR(); }
    if (NT > 1) { if constexpr (F32) SLOAD_F((const float*)Kh, KBASE(1)); else SLOAD_H(Kh, Vh, KBASE(1)); }
    SBAR(); qkt<0, SK, FB>(pA0, pA1, K_lds, r32, hi, S.qr, ACT(0), fb + (unsigned)(KBASE(0) + 4 * hi) * 4u);
    if constexpr (F32) { if (NT > 1) { VMW(); SWRITE_KF(1); SBAR(); SLOAD_F((const float*)Vh, KBASE(1)); } }
    MASKT(pA0, pA1, 0); partialSM(pA0, pA1, m_reg, mnA, alA);
    if (NT > 1) { VMW(); if constexpr (F32) { SWRITE_VF(1); SBAR(); if (NT > 2) SLOAD_F((const float*)Kh, KBASE(2)); } else SWRITE_H(1); }
    __syncthreads();
#define HALF_STEP(PX0, PX1, mnX, alX, PY0, PY1, alY, t, KB, VB, SB) do {                                                      \
        SBAR(); qkt<KB, SK, FB>(PX0, PX1, K_lds, r32, hi, S.qr, ACT(t), fb + (unsigned)(KBASE(t) + 4 * hi) * 4u);                                             \
        finishSM(PY0, PY1, alY, l_reg, pa0, pa1, pa2, pa3); SBAR();                                                           \
        if ((t) + 1 < NT) { if constexpr (F32) { VMW(); SWRITE_KF(SB); SBAR(); SLOAD_F((const float*)Vh, KBASE((t) + 1)); }  \
                            else { SLOAD_H(Kh, Vh, KBASE((t) + 1)); } SBAR(); }                                               \
        pv_tile<VB, SK>(o, vb0, pa0, pa1, pa2, pa3, ACT((t) - 1)); MASKT(PX0, PX1, (t)); partialSM(PX0, PX1, m_reg, mnX, alX);                                        \
        __syncthreads();                                                                                                      \
        if ((t) + 1 < NT) { VMW(); if constexpr (F32) { SWRITE_VF(SB); SBAR(); if ((t) + 2 < NT) SLOAD_F((const float*)Kh, KBASE((t) + 2)); } \
                            else { SWRITE_H(SB); } }                                                                          \
        RESC(alX); __syncthreads(); } while (0)
    for (int t = 1; t + 1 < NT; t += 2) {
        HALF_STEP(pB0, pB1, mnB, alB, pA0, pA1, alA, t, 1, 0, 0);
        HALF_STEP(pA0, pA1, mnA, alA, pB0, pB1, alB, t + 1, 0, 1, 1);
    }
    const bool even = (NT & 1) == 0;
    if (even) { SBAR(); qkt<1, SK, FB>(pB0, pB1, K_lds, r32, hi, S.qr, ACT(NT - 1), fb + (unsigned)(KBASE(NT - 1) + 4 * hi) * 4u); SBAR(); }
#define QROW(e) (nxt.Q + (size_t)(wid * QBLK + r32) * LDQ + ((e) >> 1) * 16 + hi * 8 + ((e) & 1) * 4)
    if constexpr (F32) { SLOAD_F((const float*)nxt.K, kbn); SBAR();
#pragma unroll
        for (int e = 0; e < 8; ++e) S.tq[e] = *(const f32x4*)QROW(e); }
    else { SLOAD_H(nxt.K, nxt.V, kbn); SBAR();
#pragma unroll
        for (int d0 = 0; d0 < 8; ++d0) S.qr[d0] = load8<TIn>(nxt.Q + BOFF(wid * QBLK + r32, d0 * 16 + hi * 8)); }
    SBAR();
    finishSM(pA0, pA1, alA, l_reg, pa0, pa1, pa2, pa3); SBAR();
    if constexpr (F32) {
#pragma unroll
        for (int e = 8; e < 16; ++e) S.tq[e] = *(const f32x4*)QROW(e); SBAR(); }
#undef QROW
    pv_tile<0, SK>(o, vb0, pa0, pa1, pa2, pa3, ACT(even ? NT - 2 : NT - 1));
    if (even) { MASKT(pB0, pB1, NT - 1); partialSM(pB0, pB1, m_reg, mnB, alB); __syncthreads(); RESC(alB);
        finishSM(pB0, pB1, alB, l_reg, pa0, pa1, pa2, pa3); SBAR(); pv_tile<1, SK>(o, vb0, pa0, pa1, pa2, pa3, ACT(NT - 1)); }
    SBAR(); SEAM_K0();
    if (hi == 0) li_l[r32] = l_reg; asm volatile("s_waitcnt lgkmcnt(0)" ::: "memory");
    float rli[16];
#pragma unroll
    for (int r = 0; r < 16; ++r) rli[r] = __builtin_amdgcn_rcpf(li_l[crow(r, hi)]);
    TOut* Ow = cur.O + (size_t)(wid * QBLK) * LDO;
#pragma unroll
    for (int r = 0; r < 16; ++r) { const int orow = crow(r, hi);
#pragma unroll
        for (int d0 = 0; d0 < 4; ++d0) { const float v = o[d0][r] * rli[r];
            if constexpr (same_t<TOut, float>::v) { Ow[(size_t)orow * LDO + d0 * 32 + r32] = v; }
            else { const float vn = __shfl_xor(v, 1);
                   if ((r32 & 1) == 0) *(unsigned*)(Ow + (size_t)orow * LDO + d0 * 32 + r32) = cvtpk(v, vn); } } }
    if constexpr (F32) {
#pragma unroll
        for (int d0 = 0; d0 < 8; ++d0) S.qr[d0] = pack8(S.tq[2 * d0], S.tq[2 * d0 + 1]); }
    __syncthreads();
#undef RESC
#undef KBASE
#undef ACT
#undef MASKT
#undef SEAM_K0
#undef HALF_STEP
}
#undef ROW
#undef VMW
#undef VMWN
#undef SLOAD_H
#undef SWRITE_HK
#undef SWRITE_HV
#undef SWRITE_H
#undef SLOAD_F
#undef SWRITE_KF
#undef SWRITE_VF
typedef _Float16 f16x8 __attribute__((ext_vector_type(8)));
__device__ __forceinline__ f16x8 pack_f16(const f32x16& v, int b) {
    u32x4 w;
    w.x = __builtin_bit_cast(unsigned, __builtin_amdgcn_cvt_pkrtz(v[b + 0], v[b + 1])); w.y = __builtin_bit_cast(unsigned, __builtin_amdgcn_cvt_pkrtz(v[b + 2], v[b + 3]));
    w.z = __builtin_bit_cast(unsigned, __builtin_amdgcn_cvt_pkrtz(v[b + 4], v[b + 5])); w.w = __builtin_bit_cast(unsigned, __builtin_amdgcn_cvt_pkrtz(v[b + 6], v[b + 7]));
    return __builtin_bit_cast(f16x8, w);
}
template <int KB, int H>
__device__ __forceinline__ void qk_half(f32x16& p, const char* K_lds, const char* Q_lds, int r32, int hi) {
    p = f32x16{};
    int ko[4];
#pragma unroll
    for (int dd = 0; dd < 4; ++dd) ko[dd] = KSWZ(r32, (dd * 16 + hi * 8) * 2);
#pragma unroll
    for (int d0 = 0; d0 < 8; ++d0) { const bf16x8 b = *reinterpret_cast<const bf16x8*>(K_lds + KB * SHM_K + H * 32 * 256 + ko[d0 & 3] + (d0 >> 2) * 128);
        const bf16x8 q = *reinterpret_cast<const bf16x8*>(Q_lds + ko[d0 & 3] + (d0 >> 2) * 128);
        p = MFMA32_H(b, q, p, 0, 0, 0);
        if (d0 & 1) SBAR(); }
}
#define SB_PK4(P, B_, OUT) do { unsigned a0 = cvtpk(P[B_+0], P[B_+1]), a1 = cvtpk(P[B_+2], P[B_+3]);                          \
        unsigned b0 = cvtpk(P[B_+4], P[B_+5]), b1 = cvtpk(P[B_+6], P[B_+7]);                                             \
        auto r0 = __builtin_amdgcn_permlane32_swap(a0, b0, false, false); auto r1 = __builtin_amdgcn_permlane32_swap(a1, b1, false, false); \
        u32x4 w = {r0[0], r1[0], r0[1], r1[1]}; OUT = *reinterpret_cast<bf16x8*>(&w); } while (0)
template <int KB, int H>
__device__ __forceinline__ void sb_half(f32x16& Racc, const char* K_lds, const char* Q_lds, int r32, int hi, int dq, bool need_mask, f16x8 tri0, f16x8 tri1, f16x8 ones, bf16x8& paA, bf16x8& paB) {
    f32x16 p, s;
    qk_half<KB, H>(p, K_lds, Q_lds, r32, hi);
#pragma unroll
    for (int r = 0; r < 16; ++r) { const float z = p[r]; const float e = __builtin_amdgcn_exp2f(-__builtin_fabsf(z)); const float sp = fmaxf(z, 0.f) + __builtin_amdgcn_logf(1.f + e); s[r] = sp; p[r] = z - sp; }
    if (need_mask) { const float NEG = -__builtin_inff();
#pragma unroll
        for (int r = 0; r < 16; ++r) { const int c = (r & 3) + 8 * (r >> 2) + 32 * H; if (!(c < dq)) { s[r] = 0.f; p[r] = NEG; } } }
    const f16x8 La = pack_f16(s, 0), Lb = pack_f16(s, 8);
    f32x16 C = __builtin_amdgcn_mfma_f32_32x32x16_f16(tri0, La, Racc, 0, 0, 0); C = __builtin_amdgcn_mfma_f32_32x32x16_f16(tri1, Lb, C, 0, 0, 0);
    Racc = __builtin_amdgcn_mfma_f32_32x32x16_f16(ones, La, Racc, 0, 0, 0); Racc = __builtin_amdgcn_mfma_f32_32x32x16_f16(ones, Lb, Racc, 0, 0, 0);
#pragma unroll
    for (int r = 0; r < 16; ++r) p[r] = __builtin_amdgcn_exp2f(p[r] - C[r]);
    SB_PK4(p, 0, paA); SB_PK4(p, 8, paB);
}
template <int KB>
__device__ __forceinline__ void sb_tile(f32x16* o, f32x16& Racc, const char* K_lds, const char* Q_lds, int vb0, int r32, int hi, int dq, bool need_mask, f16x8 tri0, f16x8 tri1, f16x8 ones) {
    bf16x8 pa0, pa1, pa2, pa3;
    sb_half<KB, 1>(Racc, K_lds, Q_lds, r32, hi, dq, need_mask, tri0, tri1, ones, pa2, pa3);
    SBAR();
    sb_half<KB, 0>(Racc, K_lds, Q_lds, r32, hi, dq, need_mask, tri0, tri1, ones, pa0, pa1);
    pv_tile<KB, false>(o, vb0, pa0, pa1, pa2, pa3, true);
}
__device__ __forceinline__ void sb_block(const bf16* Q, const bf16* K, const bf16* V, bf16* O, int P0, char* lds, volatile int* dead_flags  ) {
    int tid = threadIdx.x; asm volatile("" : "+v"(tid)); const int wid = __builtin_amdgcn_readfirstlane(tid >> 6), lane = tid & 63, r32 = lane & 31, hi = lane >> 5;
    const int NT = P0 / KVBLK + QB / KVBLK;
    const int qlo = P0 + wid * QBLK, qpos = qlo + r32;
    char* V_lds = lds; char* K_lds = lds + 2 * SHM_V;
    const int sr = ST_ROW(tid), sc = ST_COL(tid), vst0 = v_st(sr, sc), vst1 = v_st(32 + sr, sc), kws = KSWZ(sr, sc * 2);
    const int vb0 = (int)(uintptr_t)V_lds + v_rd_base(lane);
    char* Q_lds = lds + 2 * SHM_V + 2 * SHM_K + wid * (QBLK * 256);
#pragma unroll
    for (int d0 = 0; d0 < 8; ++d0) *(bf16x8*)(Q_lds + KSWZ(r32, (d0 * 16 + hi * 8) * 2)) = load8<bf16>(Q + BOFF(wid * QBLK + r32, d0 * 16 + hi * 8));
    f16x8 tri0, tri1, ones;
#pragma unroll
    for (int j = 0; j < 8; ++j) { const int ka = 8 * (j >> 2) + 4 * hi + (j & 3); tri0[j] = (ka > r32) ? (_Float16)1.f : (_Float16)0.f; tri1[j] = (16 + ka > r32) ? (_Float16)1.f : (_Float16)0.f; ones[j] = (_Float16)1.f; }
    float zero = 0.f; asm volatile("" : "+v"(zero));
    f32x16 Racc, o[4];
#pragma unroll
    for (int r = 0; r < 16; ++r) { Racc[r] = zero; o[0][r] = zero; o[1][r] = zero; o[2][r] = zero; o[3][r] = zero; }
    bf16x8 st_k0, st_k1, st_v0, st_v1;
    const unsigned rowoff = (unsigned)BOFF(sr, sc);
#define SB_LOAD(k0) do { const bf16* kt_ = K + BOFF((k0), 0); const bf16* vt_ = V + BOFF((k0), 0); \
                         st_v0 = load8<bf16>(vt_ + rowoff); st_v1 = load8<bf16>(vt_ + BOFF(32, 0) + rowoff); \
                         st_k0 = load8<bf16>(kt_ + rowoff); st_k1 = load8<bf16>(kt_ + BOFF(32, 0) + rowoff); } while (0)
#define SB_WRITE(bf) do { *(bf16x8*)(K_lds + (bf) * SHM_K + kws) = st_k0; *(bf16x8*)(K_lds + (bf) * SHM_K + kws + 32 * 256) = st_k1; \
                          *(bf16x8*)(V_lds + (bf) * SHM_V + vst0) = st_v0; *(bf16x8*)(V_lds + (bf) * SHM_V + vst1) = st_v1; } while (0)
    SB_LOAD((NT - 1) * KVBLK); asm volatile("s_waitcnt vmcnt(0)" ::: "memory"); SB_WRITE((NT - 1) & 1);
    if (tid < NW) dead_flags[tid] = -1;
    __syncthreads();
    bool dead = false;
    for (int t = NT - 1; t >= 0; --t) {
        const int kb = t * KVBLK;
        if (t > 0) SB_LOAD(kb - KVBLK);
        if (!dead && kb < qlo + QBLK - 1) {
            const bool need_mask = kb + KVBLK - 1 >= qlo; const int dq = qpos - kb - 4 * hi;
            if (t & 1) sb_tile<1>(o, Racc, K_lds, Q_lds, vb0, r32, hi, dq, need_mask, tri0, tri1, ones);
            else       sb_tile<0>(o, Racc, K_lds, Q_lds, vb0, r32, hi, dq, need_mask, tri0, tri1, ones);
            dead = __all(Racc[0] >= 160.f);
            if (dead && lane == 0) dead_flags[wid] = t;
        }
        if (t > 0) { asm volatile("s_waitcnt vmcnt(0)" ::: "memory"); SB_WRITE((t - 1) & 1); }
        __syncthreads();
        int nd = 0;
#pragma unroll
        for (int w = 0; w < NW; ++w) nd += (dead_flags[w] >= t) ? 1 : 0;
        if (nd == NW) break;
    }
#undef SB_LOAD
#undef SB_WRITE
    int tid2 = threadIdx.x; asm volatile("" : "+v"(tid2));
    const int r32e = tid2 & 31, hie = (tid2 >> 5) & 1;
    bf16* Ow = O + (size_t)(wid * QBLK) * LDO;
#pragma unroll
    for (int r = 0; r < 16; ++r) { const int orow = crow(r, hie);
#pragma unroll
        for (int d0 = 0; d0 < 4; ++d0) { const float v = o[d0][r]; const float vn = __shfl_xor(v, 1);
            if ((r32e & 1) == 0) *(unsigned*)(Ow + (size_t)orow * LDO + d0 * 32 + r32e) = cvtpk(v, vn); } }
}
}
namespace dsa {
#define DLAS __attribute__((address_space(3)))
typedef short bf16x8 __attribute__((ext_vector_type(8)));
typedef short s16x4 __attribute__((ext_vector_type(4)));
typedef float f32x4 __attribute__((ext_vector_type(4)));
typedef float f32x16 __attribute__((ext_vector_type(16)));
typedef unsigned u32x4 __attribute__((ext_vector_type(4)));
typedef unsigned u32x2 __attribute__((ext_vector_type(2)));
typedef unsigned short bf16_t;
constexpr int LDP = 3584, LDO = 2048, S = 4096;
constexpr int C_K = 2048, C_V = 2176, C_QI = 2304, C_KI = 3328, C_WI = 3392;
constexpr int NWAVE_ = 8, KI_ROW = 144, KI_TILE = 128 * KI_ROW, KI_LDS = 2 * KI_TILE;
constexpr int VROW = 288, WAVE_LDS = 32 * VROW + 512;
__device__ __forceinline__ unsigned cvtpk(float lo, float hi) { unsigned r; asm volatile("v_cvt_pk_f16_f32 %0, %1, %2" : "=v"(r) : "v"(lo), "v"(hi)); return r; }
typedef _Float16 h16x8 __attribute__((ext_vector_type(8)));
__device__ __forceinline__ float bf2f(unsigned short v) { return (float)__builtin_bit_cast(_Float16, v); }

__device__ __forceinline__ void indexer2(const bf16_t* P, int tq0, int n_adm, float* Iscr, int lane_) {
    int lane = lane_; asm volatile("" : "+v"(lane));
    const int r32 = lane & 31, hi = lane >> 5;
    bf16x8 aq[2][4]; float wA[2][8], wB[2][8];
#pragma unroll
    for (int p = 0; p < 2; ++p) {
        const bf16_t* src = P + (unsigned)((tq0 + 2 * p + (r32 >> 4)) * LDP + C_QI + (r32 & 15) * 64 + hi * 8);
#pragma unroll
        for (int s = 0; s < 4; ++s) aq[p][s] = *(const bf16x8*)(src + 16 * s);
        const bf16_t* wa = P + (unsigned)((tq0 + 2 * p) * LDP + C_WI + 4 * hi); const bf16_t* wb = wa + LDP;
        const u32x2 a0 = *(const u32x2*)wa, a1 = *(const u32x2*)(wa + 8), b0 = *(const u32x2*)wb, b1 = *(const u32x2*)(wb + 8);
        const float sc = 1.0f / 32.0f;
        wA[p][0] = bf2f(a0.x & 0xffff) * sc; wA[p][1] = bf2f(a0.x >> 16) * sc; wA[p][2] = bf2f(a0.y & 0xffff) * sc; wA[p][3] = bf2f(a0.y >> 16) * sc;
        wA[p][4] = bf2f(a1.x & 0xffff) * sc; wA[p][5] = bf2f(a1.x >> 16) * sc; wA[p][6] = bf2f(a1.y & 0xffff) * sc; wA[p][7] = bf2f(a1.y >> 16) * sc;
        wB[p][0] = bf2f(b0.x & 0xffff) * sc; wB[p][1] = bf2f(b0.x >> 16) * sc; wB[p][2] = bf2f(b0.y & 0xffff) * sc; wB[p][3] = bf2f(b0.y >> 16) * sc;
        wB[p][4] = bf2f(b1.x & 0xffff) * sc; wB[p][5] = bf2f(b1.x >> 16) * sc; wB[p][6] = bf2f(b1.y & 0xffff) * sc; wB[p][7] = bf2f(b1.y >> 16) * sc;
    }
    const unsigned koff = (unsigned)(r32 * LDP + C_KI + 8 * hi);
    const int nt = n_adm >> 5;
    bf16x8 bk[4], bn[4];
#pragma unroll
    for (int s = 0; s < 4; ++s) bk[s] = *(const bf16x8*)(P + koff + 16 * s);
    for (int j = 0; j < nt; ++j) {
        const bf16_t* kn = P + (size_t)((j + 1 < nt) ? (j + 1) * 32 : j * 32) * LDP;
#pragma unroll
        for (int s = 0; s < 4; ++s) bn[s] = *(const bf16x8*)(kn + koff + 16 * s);
#pragma unroll
        for (int p = 0; p < 2; ++p) {
            f32x16 acc = {};
#pragma unroll
            for (int s = 0; s < 4; ++s) acc = __builtin_amdgcn_mfma_f32_32x32x16_f16(__builtin_bit_cast(h16x8, aq[p][s]), __builtin_bit_cast(h16x8, bk[s]), acc, 0, 0, 0);
            float ia = 0.f, ib = 0.f;
#pragma unroll
            for (int r = 0; r < 8; ++r) { ia = __builtin_fmaf(fmaxf(acc[r], 0.f), wA[p][r], ia); ib = __builtin_fmaf(fmaxf(acc[8 + r], 0.f), wB[p][r], ib); }
            asm volatile("s_nop 1\n\tv_permlane32_swap_b32 %0, %1" : "+v"(ia), "+v"(ib));
            const float v = ia + ib;
            Iscr[(unsigned)((2 * p + hi) * S + 32 * j + r32)] = v;
        }
#pragma unroll
        for (int s = 0; s < 4; ++s) bk[s] = bn[s];
    }
    const int npad = (n_adm + 511) & ~511;
    for (int i = n_adm + lane; i < npad; i += 64) {
#pragma unroll
        for (int q = 0; q < 4; ++q) Iscr[(unsigned)(q * S + i)] = -__builtin_inff(); }
}

template <int MODE>
__device__ __forceinline__ void indexer_wg(const bf16_t* P, int tq0, int n_adm, float* Iscr, DLAS char* kbuf, int tid_) {
    int tid = tid_; asm volatile("" : "+v"(tid));
    const int lane = tid & 63, r32 = lane & 31, hi = lane >> 5;
    bf16x8 aq[2][4]; float wA[2][8], wB[2][8];
#pragma unroll
    for (int p = 0; p < 2; ++p) {
        const bf16_t* src = P + (unsigned)((tq0 + 2 * p + (r32 >> 4)) * LDP + C_QI + (r32 & 15) * 64 + hi * 8);
#pragma unroll
        for (int s = 0; s < 4; ++s) aq[p][s] = *(const bf16x8*)(src + 16 * s);
        const bf16_t* wa = P + (unsigned)((tq0 + 2 * p) * LDP + C_WI + 4 * hi); const bf16_t* wb = wa + LDP;
        const u32x2 a0 = *(const u32x2*)wa, a1 = *(const u32x2*)(wa + 8), b0 = *(const u32x2*)wb, b1 = *(const u32x2*)(wb + 8);
        const float sc = 1.0f / 32.0f;
        wA[p][0] = bf2f(a0.x & 0xffff) * sc; wA[p][1] = bf2f(a0.x >> 16) * sc; wA[p][2] = bf2f(a0.y & 0xffff) * sc; wA[p][3] = bf2f(a0.y >> 16) * sc;
        wA[p][4] = bf2f(a1.x & 0xffff) * sc; wA[p][5] = bf2f(a1.x >> 16) * sc; wA[p][6] = bf2f(a1.y & 0xffff) * sc; wA[p][7] = bf2f(a1.y >> 16) * sc;
        wB[p][0] = bf2f(b0.x & 0xffff) * sc; wB[p][1] = bf2f(b0.x >> 16) * sc; wB[p][2] = bf2f(b0.y & 0xffff) * sc; wB[p][3] = bf2f(b0.y >> 16) * sc;
        wB[p][4] = bf2f(b1.x & 0xffff) * sc; wB[p][5] = bf2f(b1.x >> 16) * sc; wB[p][6] = bf2f(b1.y & 0xffff) * sc; wB[p][7] = bf2f(b1.y >> 16) * sc;
    }
    const int srow = tid >> 3, sch = tid & 7;
    const unsigned sgo = (unsigned)(srow * LDP + C_KI + sch * 8);
    const unsigned slo = (unsigned)(srow * KI_ROW + (sch << 4));
    unsigned rdo[4];
#pragma unroll
    for (int s = 0; s < 4; ++s) rdo[s] = (unsigned)(r32 * KI_ROW + ((2 * s + hi) << 4));
    const int nt = (n_adm + 127) >> 7;
    const unsigned kb0 = (unsigned)(uintptr_t)kbuf;
    bf16x8 st0 = *(const bf16x8*)(P + sgo), st1 = *(const bf16x8*)(P + sgo + 64 * LDP);
    *(DLAS bf16x8*)(kb0 + slo) = st0; *(DLAS bf16x8*)(kb0 + slo + 64 * KI_ROW) = st1;
    __syncthreads();
    float pend[2][4]; int pend_kt = -1, pend_n = 0;
    for (int kt = 0; kt < nt; ++kt) {
        const unsigned cur = kb0 + (unsigned)((kt & 1) * KI_TILE), nxt = kb0 + (unsigned)(((kt + 1) & 1) * KI_TILE);
        if (pend_kt >= 0) {
#pragma unroll
            for (int sub = 0; sub < 4; ++sub) if (sub < pend_n) {
#pragma unroll
                for (int p = 0; p < 2; ++p) Iscr[(unsigned)((2 * p + hi) * S + pend_kt * 128 + sub * 32 + r32)] = pend[p][sub]; } }
        if (MODE != 2 && kt + 1 < nt) { const bf16_t* tp = P + (size_t)(kt + 1) * 128 * LDP; st0 = *(const bf16x8*)(tp + sgo); st1 = *(const bf16x8*)(tp + sgo + 64 * LDP); }
        const int nsub = (n_adm - kt * 128) >= 128 ? 4 : 2;
#pragma unroll
        for (int sp = 0; sp < 2; ++sp) if (MODE != 3 && 2 * sp < nsub) {
            bf16x8 bk[2][4];
#pragma unroll
            for (int u = 0; u < 2; ++u)
#pragma unroll
                for (int s = 0; s < 4; ++s) bk[u][s] = *(DLAS const bf16x8*)(cur + (unsigned)((2 * sp + u) * 32 * KI_ROW) + rdo[s]);
            f32x16 acc[2][2];
#pragma unroll
            for (int u = 0; u < 2; ++u)
#pragma unroll
                for (int p = 0; p < 2; ++p) acc[u][p] = (f32x16){};
#pragma unroll
            for (int s = 0; s < 4; ++s)
#pragma unroll
                for (int u = 0; u < 2; ++u)
#pragma unroll
                    for (int p = 0; p < 2; ++p) acc[u][p] = __builtin_amdgcn_mfma_f32_32x32x16_f16(__builtin_bit_cast(h16x8, aq[p][s]), __builtin_bit_cast(h16x8, bk[u][s]), acc[u][p], 0, 0, 0);
#pragma unroll
            for (int u = 0; u < 2; ++u)
#pragma unroll
                for (int p = 0; p < 2; ++p) {
                    float ia = 0.f, ib = 0.f;
                    if (MODE == 4) { asm volatile("" :: "v"(acc[u][p])); pend[p][2 * sp + u] = 0.f; continue; }
                    if (MODE == 1) { ia = acc[u][p][0]; ib = acc[u][p][8]; } else
#pragma unroll
                    for (int r = 0; r < 8; ++r) { ia = __builtin_fmaf(fmaxf(acc[u][p][r], 0.f), wA[p][r], ia); ib = __builtin_fmaf(fmaxf(acc[u][p][8 + r], 0.f), wB[p][r], ib); }
                    asm volatile("s_nop 1\n\tv_permlane32_swap_b32 %0, %1" : "+v"(ia), "+v"(ib));
                    pend[p][2 * sp + u] = ia + ib;
                }
        }
        pend_kt = kt; pend_n = nsub;
        if (MODE != 2) { if (kt + 1 < nt) { *(DLAS bf16x8*)(nxt + slo) = st0; *(DLAS bf16x8*)(nxt + slo + 64 * KI_ROW) = st1; }
        __syncthreads(); }
    }
#pragma unroll
    for (int sub = 0; sub < 4; ++sub) if (sub < pend_n) {
#pragma unroll
        for (int p = 0; p < 2; ++p) Iscr[(unsigned)((2 * p + hi) * S + pend_kt * 128 + sub * 32 + r32)] = pend[p][sub]; }
    const int npad = (n_adm + 511) & ~511;
    for (int i = n_adm + lane; i < npad; i += 64) {
#pragma unroll
        for (int q = 0; q < 4; ++q) Iscr[(unsigned)(q * S + i)] = -__builtin_inff(); }
}

__device__ __forceinline__ unsigned ordkey(float v) { const unsigned u = __builtin_bit_cast(unsigned, v); return (u & 0x80000000u) ? ~u : (u | 0x80000000u); }
__device__ __forceinline__ void topk256(const float* Irow, int n_adm, DLAS unsigned short* list, DLAS char* cbuf, int lane_) {
    int lane = lane_; asm volatile("" : "+v"(lane));
    const int nreg = n_adm >> 6;
    DLAS float* cv = (DLAS float*)cbuf; DLAS unsigned short* ci = (DLAS unsigned short*)(cbuf + 4096);
    unsigned key[16];
    const bool direct = nreg <= 16;
    if (direct) {
#pragma unroll
        for (int g8 = 0; g8 < 2; ++g8) {
            if (8 * g8 < nreg) {
#pragma unroll
                for (int jj = 0; jj < 8; ++jj) key[8 * g8 + jj] = ordkey(Irow[64 * (8 * g8 + jj) + lane]); }
            else {
#pragma unroll
                for (int jj = 0; jj < 8; ++jj) key[8 * g8 + jj] = 0u; } }
    } else {
        float v[64];
#pragma unroll
        for (int g8 = 0; g8 < 8; ++g8) {
            if (8 * g8 < nreg) {
#pragma unroll
                for (int jj = 0; jj < 8; ++jj) v[8 * g8 + jj] = Irow[64 * (8 * g8 + jj) + lane]; }
            else {
#pragma unroll
                for (int jj = 0; jj < 8; ++jj) v[8 * g8 + jj] = -__builtin_inff(); } }
        float s1 = 0.f, s2 = 0.f;
#pragma unroll
        for (int j = 0; j < 16; ++j) { s1 += v[j]; s2 = __builtin_fmaf(v[j], v[j], s2); }
#pragma unroll
        for (int o = 1; o < 64; o <<= 1) { s1 += __shfl_xor(s1, o); s2 += __shfl_xor(s2, o); }
        const float mu = s1 * (1.f / 1024.f), sd = sqrtf(fmaxf(s2 * (1.f / 1024.f) - mu * mu, 1e-20f));
        const float pq = 512.f / (float)n_adm, tq = sqrtf(-2.f * __logf(pq));
        const float zq = tq - (2.515517f + tq * (0.802853f + tq * 0.010328f)) / (1.f + tq * (1.432788f + tq * (0.189269f + tq * 0.001308f)));
        float L = mu + zq * sd; int c = 0;
        for (int tries = 0; tries < 64; ++tries) {
            int base = 0;
#pragma unroll
            for (int g8 = 0; g8 < 8; ++g8) if (8 * g8 < nreg) {
#pragma unroll
                for (int jj = 0; jj < 8; ++jj) { const int j = 8 * g8 + jj; const bool sel = v[j] > L; const unsigned long long m = __ballot(sel);
                    const int pos = base + (int)__builtin_amdgcn_mbcnt_hi((unsigned)(m >> 32), __builtin_amdgcn_mbcnt_lo((unsigned)m, 0u));
                    if (sel && pos < 1024) { cv[pos] = v[j]; ci[pos] = (unsigned short)(64 * j + lane); } base += __builtin_popcountll(m);
                    if ((jj & 3) == 3) __builtin_amdgcn_sched_barrier(0); } }
            c = base;
            if (c < 256) { L -= 0.35f * sd; continue; }
            if (c > 1024) { L += 0.35f * sd; continue; }
            break;
        }
        asm volatile("s_waitcnt lgkmcnt(0)" ::: "memory");
#pragma unroll
        for (int j = 0; j < 16; ++j) { const int i = 64 * j + lane; key[j] = (i < c) ? ordkey(cv[i]) : 0u; }
    }
    unsigned lo = 0u, hi = 0xFFFFFFFFu, thr; int cnt_hi = 0, need = 0;
    for (;;) {
        const unsigned mid = lo + ((hi - lo) >> 1);
        if (mid == lo) { thr = hi; need = 256 - cnt_hi; break; }
        int c = 0;
#pragma unroll
        for (int j = 0; j < 16; ++j) { c += __builtin_popcountll(__ballot(key[j] > mid)); if ((j & 3) == 3) __builtin_amdgcn_sched_barrier(0); }
        if (c == 256) { thr = mid; need = 0; break; }
        if (c > 256) lo = mid; else { hi = mid; cnt_hi = c; }
    }
    int base = 0;
#pragma unroll
    for (int j = 0; j < 16; ++j) { const bool sel = key[j] > thr; const unsigned long long m = __ballot(sel);
        const int pos = base + (int)__builtin_amdgcn_mbcnt_hi((unsigned)(m >> 32), __builtin_amdgcn_mbcnt_lo((unsigned)m, 0u));
        const unsigned short idx = direct ? (unsigned short)(64 * j + lane) : ci[64 * j + lane];
        if (sel && pos < 256) list[pos] = idx; base += __builtin_popcountll(m); }
    if (need > 0) {
#pragma unroll
        for (int j = 0; j < 16; ++j) { const bool sel = key[j] == thr; const unsigned long long m = __ballot(sel);
            const int pos = base + (int)__builtin_amdgcn_mbcnt_hi((unsigned)(m >> 32), __builtin_amdgcn_mbcnt_lo((unsigned)m, 0u));
            const unsigned short idx = direct ? (unsigned short)(64 * j + lane) : ci[64 * j + lane];
            if (sel && pos < 256) list[pos] = idx; base += __builtin_popcountll(m); }
    }
}

#define DSA_TRRD(dst, addr, off) asm volatile("ds_read_b64_tr_b16 %0, %1 offset:%2" : "=&v"(dst) : "v"(addr), "i"(off) : "memory")
__device__ __forceinline__ void sparse_attn(const bf16_t* P, int t, DLAS const unsigned short* list, int nv, DLAS char* vbuf, bf16_t* Orow, int lane_, const unsigned char* K8 = nullptr) {
    int lane = lane_; asm volatile("" : "+v"(lane));
    const int c16 = lane & 15, g = lane >> 4;
#if DSA_K8
    typedef int i32x4k __attribute__((ext_vector_type(4)));
    i32x4k q8[2]; float sqk;
    { const bf16_t* qp8 = P + (unsigned)(t * LDP + c16 * 128 + 16 * g); bf16x8 qf[2][2];
#pragma unroll
      for (int s = 0; s < 2; ++s) { qf[s][0] = *(const bf16x8*)(qp8 + 64 * s); qf[s][1] = *(const bf16x8*)(qp8 + 64 * s + 8); }
      float qv[32]; float mx = 0.f;
#pragma unroll
      for (int s = 0; s < 2; ++s)
#pragma unroll
          for (int hh = 0; hh < 2; ++hh)
#pragma unroll
              for (int j = 0; j < 8; ++j) { const float v = bf2f((unsigned short)qf[s][hh][j]); qv[16 * s + 8 * hh + j] = v; mx = fmaxf(mx, fabsf(v)); }
      mx = fmaxf(mx, __shfl_xor(mx, 16)); mx = fmaxf(mx, __shfl_xor(mx, 32)); mx = fmaxf(mx, 1e-30f);
      const float qs = 127.f / mx; sqk = mx * (1.f / 127.f) * (6.f / 127.f);
#pragma unroll
      for (int s = 0; s < 2; ++s) { q8[s][0] = (int)pk_i8x4(qv[16 * s + 0], qv[16 * s + 1], qv[16 * s + 2], qv[16 * s + 3], qs); q8[s][1] = (int)pk_i8x4(qv[16 * s + 4], qv[16 * s + 5], qv[16 * s + 6], qv[16 * s + 7], qs);
          q8[s][2] = (int)pk_i8x4(qv[16 * s + 8], qv[16 * s + 9], qv[16 * s + 10], qv[16 * s + 11], qs); q8[s][3] = (int)pk_i8x4(qv[16 * s + 12], qv[16 * s + 13], qv[16 * s + 14], qv[16 * s + 15], qs); } }
#else
    const bf16_t* qp = P + (unsigned)(t * LDP + c16 * 128 + 8 * g);
    bf16x8 bq[4];
#pragma unroll
    for (int s = 0; s < 4; ++s) bq[s] = *(const bf16x8*)(qp + 32 * s);
#endif
    const int nks = nv >> 5;
    const float NEG = -__builtin_inff();
#if DSA_K8
    i32x4k kx[2][2], ky[2][2], kz[2][2], kw[2][2], ku[2][2], kv[2][2];
#define DSA_KLOAD(buf, pi) do { _Pragma("unroll") for (int k2 = 0; k2 < 2; ++k2) { const int key = list[16 * (2 * (pi) + k2) + c16]; const unsigned char* kp = K8 + (unsigned)(key * 128 + 16 * g); \
        _Pragma("unroll") for (int s = 0; s < 2; ++s) buf[k2][s] = *(const i32x4k*)(kp + 64 * s); } } while (0)
#define DSA_KCOMP(buf, pi) do { _Pragma("unroll") for (int k2 = 0; k2 < 2; ++k2) { i32x4k acci = {0, 0, 0, 0}; \
        _Pragma("unroll") for (int s = 0; s < 2; ++s) acci = __builtin_amdgcn_mfma_i32_16x16x64_i8(buf[k2][s], q8[s], acci, 0, 0, 0); \
        st[2 * (pi) + k2] = __builtin_convertvector(acci, f32x4) * sqk; } } while (0)
#else
    bf16x8 kx[2][4], ky[2][4], kz[2][4];
#define DSA_KLOAD(buf, pi) do { _Pragma("unroll") for (int k2 = 0; k2 < 2; ++k2) { const int key = list[16 * (2 * (pi) + k2) + c16]; const bf16_t* kp = P + (unsigned)(key * LDP + C_K + 8 * g); \
        _Pragma("unroll") for (int s = 0; s < 4; ++s) buf[k2][s] = *(const bf16x8*)(kp + 32 * s); } } while (0)
#define DSA_KCOMP(buf, pi) do { _Pragma("unroll") for (int k2 = 0; k2 < 2; ++k2) { f32x4 acc = {0.f, 0.f, 0.f, 0.f}; \
        _Pragma("unroll") for (int s = 0; s < 4; ++s) acc = __builtin_amdgcn_mfma_f32_16x16x32_f16(__builtin_bit_cast(h16x8, buf[k2][s]), __builtin_bit_cast(h16x8, bq[s]), acc, 0, 0, 0); \
        st[2 * (pi) + k2] = acc; } } while (0)
#endif
#define DSA_KNEG(pi) do { st[2 * (pi)] = (f32x4){NEG, NEG, NEG, NEG}; st[2 * (pi) + 1] = (f32x4){NEG, NEG, NEG, NEG}; } while (0)
    f32x4 st[16];
    const int npair = nks;
#if DSA_K8
    DSA_KLOAD(kx, 0); DSA_KLOAD(ky, 1); if (npair > 2) { DSA_KLOAD(kz, 2); DSA_KLOAD(kw, 3); } if (npair > 4) { DSA_KLOAD(ku, 4); DSA_KLOAD(kv, 5); }
    DSA_KCOMP(kx, 0); if (npair > 6) DSA_KLOAD(kx, 6);
    DSA_KCOMP(ky, 1); if (npair > 6) DSA_KLOAD(ky, 7);
    if (npair > 2) { DSA_KCOMP(kz, 2); DSA_KCOMP(kw, 3); } else { DSA_KNEG(2); DSA_KNEG(3); }
    if (npair > 4) { DSA_KCOMP(ku, 4); DSA_KCOMP(kv, 5); } else { DSA_KNEG(4); DSA_KNEG(5); }
    if (npair > 6) { DSA_KCOMP(kx, 6); DSA_KCOMP(ky, 7); } else { DSA_KNEG(6); DSA_KNEG(7); }
#else
    DSA_KLOAD(kx, 0); DSA_KLOAD(ky, 1); if (npair > 2) DSA_KLOAD(kz, 2);
    DSA_KCOMP(kx, 0); if (npair > 3) DSA_KLOAD(kx, 3);
    DSA_KCOMP(ky, 1); if (npair > 4) DSA_KLOAD(ky, 4);
    if (npair > 2) { DSA_KCOMP(kz, 2); if (npair > 5) DSA_KLOAD(kz, 5); DSA_KCOMP(kx, 3); if (npair > 6) DSA_KLOAD(kx, 6); } else { DSA_KNEG(2); DSA_KNEG(3); }
    if (npair > 4) { DSA_KCOMP(ky, 4); if (npair > 7) DSA_KLOAD(ky, 7); DSA_KCOMP(kz, 5); } else { DSA_KNEG(4); DSA_KNEG(5); }
    if (npair > 6) { DSA_KCOMP(kx, 6); DSA_KCOMP(ky, 7); } else { DSA_KNEG(6); DSA_KNEG(7); }
#endif
#undef DSA_KLOAD
#undef DSA_KCOMP
#undef DSA_KNEG
    bf16x8 va_[8], vb_[8];
#define DSA_VGATHER(buf, ks) do { _Pragma("unroll") for (int e = 0; e < 8; ++e) { const int key = list[32 * (ks) + g + 4 * e]; buf[e] = *(const bf16x8*)(P + (unsigned)(key * LDP + C_V + c16 * 8)); } } while (0)
    DSA_VGATHER(va_, 0); DSA_VGATHER(vb_, 1);
    float m = NEG;
#pragma unroll
    for (int kt = 0; kt < 16; ++kt) m = fmaxf(fmaxf(fmaxf(m, st[kt][0]), fmaxf(st[kt][1], st[kt][2])), st[kt][3]);
    m = fmaxf(m, __shfl_xor(m, 16)); m = fmaxf(m, __shfl_xor(m, 32));
    float l = 0.f;
#pragma unroll
    for (int kt = 0; kt < 16; ++kt) {
#pragma unroll
        for (int i = 0; i < 4; ++i) { const float p = __builtin_amdgcn_exp2f(st[kt][i] - m); st[kt][i] = p; l += p; } }
    l += __shfl_xor(l, 16); l += __shfl_xor(l, 32);
    f32x4 oacc[8];
#pragma unroll
    for (int rb = 0; rb < 8; ++rb) oacc[rb] = (f32x4){0.f, 0.f, 0.f, 0.f};
    const unsigned vwr = (unsigned)(uintptr_t)vbuf + (unsigned)(g * VROW + c16 * 16);
    const unsigned vrd = (unsigned)(uintptr_t)vbuf + (unsigned)((4 * g + (c16 >> 2)) * VROW + (c16 & 3) * 8);
#define DSA_VSTEP(buf, ks) do { \
        _Pragma("unroll") for (int e = 0; e < 8; ++e) *(DLAS bf16x8*)(vwr + (unsigned)(4 * e * VROW)) = buf[e]; \
        if ((ks) + 2 < nks) DSA_VGATHER(buf, (ks) + 2); \
        u32x4 w; w.x = cvtpk(st[2 * (ks)][0], st[2 * (ks)][1]); w.y = cvtpk(st[2 * (ks)][2], st[2 * (ks)][3]); w.z = cvtpk(st[2 * (ks) + 1][0], st[2 * (ks) + 1][1]); w.w = cvtpk(st[2 * (ks) + 1][2], st[2 * (ks) + 1][3]); \
        const bf16x8 pb = __builtin_bit_cast(bf16x8, w); \
        s16x4 ta[8], tb[8]; \
        DSA_TRRD(ta[0], vrd, 0); DSA_TRRD(tb[0], vrd, 16 * VROW); DSA_TRRD(ta[1], vrd, 32); DSA_TRRD(tb[1], vrd, 16 * VROW + 32); DSA_TRRD(ta[2], vrd, 64); DSA_TRRD(tb[2], vrd, 16 * VROW + 64); DSA_TRRD(ta[3], vrd, 96); DSA_TRRD(tb[3], vrd, 16 * VROW + 96); \
        DSA_TRRD(ta[4], vrd, 128); DSA_TRRD(tb[4], vrd, 16 * VROW + 128); DSA_TRRD(ta[5], vrd, 160); DSA_TRRD(tb[5], vrd, 16 * VROW + 160); DSA_TRRD(ta[6], vrd, 192); DSA_TRRD(tb[6], vrd, 16 * VROW + 192); DSA_TRRD(ta[7], vrd, 224); DSA_TRRD(tb[7], vrd, 16 * VROW + 224); \
        asm volatile("s_waitcnt lgkmcnt(0)" ::: "memory"); __builtin_amdgcn_sched_barrier(0); \
        _Pragma("unroll") for (int rb = 0; rb < 8; ++rb) { const bf16x8 af = (bf16x8){ta[rb][0], ta[rb][1], ta[rb][2], ta[rb][3], tb[rb][0], tb[rb][1], tb[rb][2], tb[rb][3]}; \
            oacc[rb] = __builtin_amdgcn_mfma_f32_16x16x32_f16(__builtin_bit_cast(h16x8, af), __builtin_bit_cast(h16x8, pb), oacc[rb], 0, 0, 0); } } while (0)
    DSA_VSTEP(va_, 0); DSA_VSTEP(vb_, 1);
    if (nks > 2) { DSA_VSTEP(va_, 2); DSA_VSTEP(vb_, 3); }
    if (nks > 4) { DSA_VSTEP(va_, 4); DSA_VSTEP(vb_, 5); }
    if (nks > 6) { DSA_VSTEP(va_, 6); DSA_VSTEP(vb_, 7); }
#undef DSA_VSTEP
#undef DSA_VGATHER
    const float rl = 1.0f / l;
    if (L1_I8 >= 3) {
        float mx = 0.f;
#pragma unroll
        for (int rb = 0; rb < 8; ++rb) { oacc[rb] = oacc[rb] * rl; mx = fmaxf(fmaxf(mx, fmaxf(fabsf(oacc[rb][0]), fabsf(oacc[rb][1]))), fmaxf(fabsf(oacc[rb][2]), fabsf(oacc[rb][3]))); }
#pragma unroll
        for (int o_ = 1; o_ < 64; o_ <<= 1) mx = fmaxf(mx, __shfl_xor(mx, o_));
        const float qs = 127.f / fmaxf(mx, 1e-30f);
#pragma unroll
        for (int rb = 0; rb < 8; ++rb) *(unsigned*)((unsigned char*)Orow + c16 * 128 + 16 * rb + 4 * g) = pk_i8x4(oacc[rb][0], oacc[rb][1], oacc[rb][2], oacc[rb][3], qs);
    } else {
#pragma unroll
    for (int rb = 0; rb < 8; ++rb) { u32x2 w; w.x = cvtpk(oacc[rb][0] * rl, oacc[rb][1] * rl); w.y = cvtpk(oacc[rb][2] * rl, oacc[rb][3] * rl);
        *(u32x2*)(Orow + c16 * 128 + 16 * rb + 4 * g) = w; } }
}
#undef DSA_TRRD

__device__ __forceinline__ void dsa_phase(DLAS char* lds, const bf16_t* proj, float* Iscr_all, bf16_t* o, int G, int bx, const unsigned char* k8all = nullptr) {
    int tid = threadIdx.x; asm volatile("" : "+v"(tid)); const int wid = __builtin_amdgcn_readfirstlane(tid >> 6), lane = tid & 63;
    DLAS char* vbuf = lds + wid * WAVE_LDS; DLAS unsigned short* list = (DLAS unsigned short*)(vbuf + 32 * VROW);
    float* Iscr = Iscr_all + ((size_t)bx * 8 + wid) * 4 * S;
    for (int pi = bx; pi < 256; pi += G) {
        const int b = pi & 7, cp = pi >> 3;
        const bf16_t* P = proj + (size_t)b * S * LDP;
        for (int half = 0; half < 2; ++half) {
            const int c = half ? 63 - cp : cp; const int n_adm = 64 * (c + 1); const int nv = n_adm < 256 ? n_adm : 256;
            for (int pass = 0; pass < 2; ++pass) {
                const int tq0 = 64 * c + 8 * wid + 4 * pass;
                if (DSA_DUP == 1 && n_adm > 256) { indexer_wg<0>(P, tq0, n_adm, Iscr, lds + NWAVE_ * WAVE_LDS, tid); }
                if (DSA_DUP == 4 && n_adm > 256) { indexer_wg<1>(P, tq0, n_adm, Iscr, lds + NWAVE_ * WAVE_LDS, tid); }
                if (DSA_DUP == 5 && n_adm > 256) { indexer_wg<2>(P, tq0, n_adm, Iscr, lds + NWAVE_ * WAVE_LDS, tid); __syncthreads(); }
                if (DSA_DUP == 7 && n_adm > 256) { indexer_wg<4>(P, tq0, n_adm, Iscr, lds + NWAVE_ * WAVE_LDS, tid); }
                if (DSA_DUP == 6 && n_adm > 256) { indexer_wg<3>(P, tq0, n_adm, Iscr, lds + NWAVE_ * WAVE_LDS, tid); }
                if (n_adm > 256) { indexer_wg<0>(P, tq0, n_adm, Iscr, lds + NWAVE_ * WAVE_LDS, tid); asm volatile("s_waitcnt vmcnt(0)" ::: "memory"); }
                for (int qq = 0; qq < 4; ++qq) {
#pragma unroll 1
                    for (int rep = 0; rep < (DSA_DUP == 2 ? 2 : 1); ++rep) {
                    if (n_adm > 256) topk256(Iscr + (size_t)qq * S, n_adm, list, vbuf, lane);
                    else { for (int i = lane; i < 256; i += 64) list[i] = (unsigned short)i; }
                    asm volatile("s_waitcnt lgkmcnt(0)" ::: "memory"); }
#pragma unroll 1
                    for (int rep = 0; rep < (DSA_DUP == 3 ? 2 : 1); ++rep)
                    sparse_attn(P, tq0 + qq, list, nv, vbuf, L1_I8 >= 3 ? (bf16_t*)((unsigned char*)o + ((size_t)b * S + tq0 + qq) * LDO) : o + ((size_t)b * S + tq0 + qq) * LDO, lane, k8all + (size_t)b * S * 128);
                }
            }
        }
    }
}
}
constexpr int NB = 8, SEQ = 4096, DM = 2048, MTOK = NB * SEQ, FF = 8192;
constexpr int N_IN0 = 6144, N_IN1 = 3584, W0SRC = 6152, W1SRC = 3408;
constexpr int NWAVES = 8;
constexpr float RMS_EPS = 1e-6f;
constexpr float QSCALE = 0.08838834764831845f * 1.4426950408889634f;
constexpr size_t MiB = 1u << 20;
constexpr size_t WS_CTL = 0, CTL_ZERO_BYTES = 1 * MiB;
constexpr size_t WS_MOD = 1 * MiB, WS_TAB = 2 * MiB, WS_FLOC = 3 * MiB, WS_BTOT = 4 * MiB;
constexpr size_t WS_WIN0 = 8 * MiB, WS_WOUT0 = 32 * MiB, WS_W1_0 = 40 * MiB, WS_W2_0 = 72 * MiB, WS_WIN1 = 104 * MiB, WS_WOUT1 = 118 * MiB, WS_W1_1 = 126 * MiB, WS_W2_1 = 158 * MiB;
constexpr size_t WS_H = 192 * MiB, WS_Y = 320 * MiB, WS_PROJ = 448 * MiB, WS_O = 832 * MiB, WS_HID = 448 * MiB, WS_END = 960 * MiB;
constexpr size_t WS_WIN1Q = 21 * MiB, WS_H8B = WS_O;
constexpr int N_QKV1 = 2304;
constexpr size_t WS_K8 = 26 * MiB;
constexpr size_t WS_X16 = 704 * MiB;
constexpr size_t WS_ISCR = WS_H;
constexpr int CW_BAR = 4096, CW_W1MAX = 8192, CW_W2MAX = 8193, CW_W1SQ = 8194, CW_WOMAX = 8196, CW_W1MAX0 = 8198, CW_W2MAX0 = 8199, CW_W1SQ0 = 8200, CW_CS1 = 12288, CW_CS0 = 16384;
constexpr size_t WS_SIG = WS_TAB + 65536;
constexpr size_t WS_SQP = WS_TAB + 131072;
constexpr size_t WS_ROWS = 5 * MiB, WS_RINV = 5 * MiB + 262144, WS_WINV = WS_TAB + 196608;
constexpr int N_PHASES = 16;
constexpr int RING_OFF = 0, RING_BYTES = 131072;
constexpr int LDSCTL_OFF = RING_BYTES, MISC_OFF = LDSCTL_OFF + 320;
constexpr int LDS_BYTES = 147456;
static_assert(att::LDS_BYTES <= RING_BYTES && att::LDS_SB_BYTES <= RING_BYTES && dsa::WAVE_LDS * NWAVES + dsa::KI_LDS <= RING_BYTES, "phase LDS vs ring");

#define GAS __attribute__((address_space(1)))
#define LAS __attribute__((address_space(3)))
typedef unsigned short bf16;
typedef unsigned v4u __attribute__((ext_vector_type(4)));
typedef unsigned v2u __attribute__((ext_vector_type(2)));
typedef float f32x4 __attribute__((ext_vector_type(4)));
typedef GAS unsigned gu32;
#define RLX_AGENT __ATOMIC_RELAXED, __HIP_MEMORY_SCOPE_AGENT
#define LDS_WAIT() asm volatile("s_waitcnt lgkmcnt(0)" ::: "memory")
#define VM_WAIT() asm volatile("s_waitcnt vmcnt(0)" ::: "memory")
__device__ __forceinline__ unsigned pk2(float lo, float hi) { unsigned r; asm volatile("v_cvt_pk_f16_f32 %0, %1, %2" : "=v"(r) : "v"(lo), "v"(hi)); return r; }
__device__ __forceinline__ float bflo(unsigned w) { return (float)__builtin_bit_cast(_Float16, (unsigned short)(w & 0xffffu)); }
__device__ __forceinline__ float bfhi(unsigned w) { return (float)__builtin_bit_cast(_Float16, (unsigned short)(w >> 16)); }
#define XB_TMO      128
#define XB_XCNT(j)  (256  + 64 * (j))
#define XB_XSUB(j)  (1280 + 64 * (j))
#define XB_XGEN(j)  (2304 + 64 * (j))
#define XB_TOP      3328
#define XB_TOPGEN   3392
#define XCD_BAR_WORDS 3456
#define XB_SPIN_CAP (1u << 18)

__device__ __forceinline__ unsigned xb_ld(unsigned* p)              { return __hip_atomic_load(p, __ATOMIC_RELAXED, __HIP_MEMORY_SCOPE_AGENT); }
__device__ __forceinline__ unsigned xb_add(unsigned* p, unsigned v) { return __hip_atomic_fetch_add(p, v, __ATOMIC_RELAXED, __HIP_MEMORY_SCOPE_AGENT); }
__device__ __forceinline__ unsigned xb_xcc_id() { return (unsigned)__builtin_amdgcn_s_getreg((3 << 11) | 20) & 0xFu; }
#define XB_SPIN(cond, bar) do { unsigned _sp = 0; while (cond) { __builtin_amdgcn_s_sleep(1); \
    if ((++_sp & 255u) == 0u) { if (xb_ld(&(bar)[XB_TMO])) break; if (_sp > XB_SPIN_CAP) { atomicAdd(&(bar)[XB_TMO], 1u); break; } } } } while (0)

struct XcdBarrier {
    unsigned* bar; unsigned x;
    volatile LAS unsigned* st;
};

__device__ __forceinline__ XcdBarrier xcd_barrier_post(unsigned* bar, volatile LAS unsigned* st) {
    XcdBarrier b; b.bar = bar; b.x = xb_xcc_id(); b.st = st;
    if (threadIdx.x == 0) (void)xb_add(&bar[XB_XCNT(b.x)], 1u);
    return b;
}
__device__ __forceinline__ void xcd_barrier_complete(unsigned* bar, unsigned x, unsigned& nloc, unsigned& nx) {
    const unsigned G = gridDim.x * gridDim.y * gridDim.z;
    unsigned sum, cnt, mine, sp = 0u;
    for (;;) {
        sum = 0u; cnt = 0u; mine = 0u;
#pragma unroll
        for (unsigned j = 0; j < 16; ++j) { const unsigned c = xb_ld(&bar[XB_XCNT(j)]); sum += c; cnt += (c > 0u) ? 1u : 0u; mine = (j == x) ? c : mine; }
        if (sum == G) break;
        __builtin_amdgcn_s_sleep(1);
        if ((++sp & 255u) == 0u) { if (xb_ld(&bar[XB_TMO])) break; if (sp > XB_SPIN_CAP) { atomicAdd(&bar[XB_TMO], 1u); break; } }
    }
    nloc = mine > 0u ? mine : 1u; nx = cnt > 0u ? cnt : 1u;
}

__device__ __forceinline__ void xcd_barrier(const XcdBarrier& b) {
    asm volatile("s_waitcnt vmcnt(0)" ::: "memory");
    __syncthreads();
    if (threadIdx.x == 0) {
        unsigned* bar = b.bar;
        __builtin_amdgcn_s_waitcnt(0);
        unsigned nloc = b.st[0], nx = b.st[1];
        if (nloc == 0u) { xcd_barrier_complete(bar, b.x, nloc, nx); b.st[0] = nloc; b.st[1] = nx; }
        const unsigned old = xb_add(&bar[XB_XSUB(b.x)], 1u);
        const unsigned gen = old / nloc;
        if (old + 1u == (gen + 1u) * nloc) {
            __builtin_amdgcn_fence(__ATOMIC_RELEASE, "agent");
            asm volatile("s_waitcnt vmcnt(0)" ::: "memory");
            const unsigned og = xb_add(&bar[XB_TOP], 1u);
            const unsigned tg = og / nx;
            if (og + 1u == (tg + 1u) * nx) xb_add(&bar[XB_TOPGEN], 1u);
            else XB_SPIN(xb_ld(&bar[XB_TOPGEN]) == tg, bar);
            __builtin_amdgcn_fence(__ATOMIC_ACQUIRE, "agent");
            xb_add(&bar[XB_XGEN(b.x)], 1u);
            asm volatile("s_waitcnt vmcnt(0)" ::: "memory");
        } else {
            XB_SPIN(xb_ld(&bar[XB_XGEN(b.x)]) == gen, bar);
            __builtin_amdgcn_fence(__ATOMIC_ACQUIRE, "agent");
            asm volatile("s_waitcnt vmcnt(0)" ::: "memory");
        }
    }
    __syncthreads();
}

struct Args { const void* in[12]; float* out; unsigned char* ws; int ph_lo, ph_hi; };
typedef const __attribute__((address_space(4))) Args* KArgsP;
__device__ __forceinline__ KArgsP kargs() { KArgsP p = (KArgsP)__builtin_amdgcn_kernarg_segment_ptr(); asm volatile("" : "+s"(p)); return p; }
#define KIN_F(i) ((const float*)kargs()->in[i])
#define KIN_I(i) ((const int*)kargs()->in[i])
enum { I_X = 0, I_C = 1, I_POS = 2, I_ADAW = 3, I_ADAB = 4, I_NORMG = 5, I_WOUT = 6, I_WIN0 = 7, I_BF = 8, I_WIN1 = 9, I_W1 = 10, I_W2 = 11 };
struct Frame {
    LAS unsigned char* lds;
    volatile LAS unsigned* MISC;
    gu32* ctl;
    int vcu, G;
    float* out; unsigned char* ws;
};
__device__ __forceinline__ float wave_sum(float v) {
#pragma unroll
    for (int o = 1; o < 64; o <<= 1) v += __shfl_xor(v, o);
    return v;
}
__device__ __forceinline__ float half_sum(float v) {
#pragma unroll
    for (int o = 1; o < 32; o <<= 1) v += __shfl_xor(v, o);
    return v;
}
#define YBLK(r, c) ((((size_t)(r) >> 4) * (DM >> 5) + ((size_t)(c) >> 5)) * 512 + ((size_t)(r) & 15) * 32 + ((size_t)(c) & 31))
__device__ __forceinline__ int srccol(int kind, int n) {
    if (kind == 0) return n;
    if (kind == 1) return n < 3072 ? n : n + 8;
    if (n < 2176) { const int j = n & 127; return (n - j) + (j >> 1) + 64 * (j & 1); }
    if (n < 2304) return n;
    if (n < 3392) { const int j = n & 63; return (n - j) + (j >> 1) + 32 * (j & 1); }
    if (n < 3408) return n;
    return -1;
}
template <int WMODE = 0>
__device__ __forceinline__ float p0_transpose_item(const float* W, int K, int Nsrc, int Ndst, bf16* WT, int kind, LAS float* scr, int item, int lane, float qs = 1.f) {
    float sq = 0.f;
    const int nblk = Ndst / 32, kb = item / nblk, nb = item % nblk, k0 = 64 * kb, n0 = 32 * nb;
    const int sc = srccol(kind, n0 + (lane & 31));
    float tv[32];
#pragma unroll
    for (int i = 0; i < 32; ++i) { const int kk = 2 * i + (lane >> 5); tv[i] = sc >= 0 ? W[(size_t)(k0 + kk) * Nsrc + sc] : 0.f; }
#pragma unroll
    for (int i = 0; i < 32; ++i) { const int kk = 2 * i + (lane >> 5); scr[kk * 33 + (lane & 31)] = tv[i]; }
    LDS_WAIT(); asm volatile("" ::: "memory");
    const int c = lane & 7;
#pragma unroll
    for (int j = 0; j < 4; ++j) { const int n = (lane >> 3) + 8 * j; const LAS float* s = scr + (8 * c) * 33 + n;
        v4u o; o.x = pk2(s[0 * 33], s[1 * 33]); o.y = pk2(s[2 * 33], s[3 * 33]); o.z = pk2(s[4 * 33], s[5 * 33]); o.w = pk2(s[6 * 33], s[7 * 33]);
        if (WMODE == 2) { v2u o8; o8.x = pk_i8x4s(s[0 * 33], s[1 * 33], s[2 * 33], s[3 * 33], qs, sq); o8.y = pk_i8x4s(s[4 * 33], s[5 * 33], s[6 * 33], s[7 * 33], qs, sq);
            *(GAS v2u*)((unsigned char*)WT + (size_t)(n0 + n) * K + k0 + 8 * c) = o8; }
        else if (WMODE == 1) { unsigned d0 = 0u, d1 = 0u; const float z = 512.f;
            d0 = (unsigned)__builtin_amdgcn_cvt_pk_fp8_f32(s[0 * 33] * z, s[1 * 33] * z, (int)d0, false); d0 = (unsigned)__builtin_amdgcn_cvt_pk_fp8_f32(s[2 * 33] * z, s[3 * 33] * z, (int)d0, true);
            d1 = (unsigned)__builtin_amdgcn_cvt_pk_fp8_f32(s[4 * 33] * z, s[5 * 33] * z, (int)d1, false); d1 = (unsigned)__builtin_amdgcn_cvt_pk_fp8_f32(s[6 * 33] * z, s[7 * 33] * z, (int)d1, true);
            v2u o8; o8.x = d0; o8.y = d1; *(GAS v2u*)((unsigned char*)WT + (size_t)(n0 + n) * K + k0 + 8 * c) = o8; }
        else *(GAS v4u*)(WT + (size_t)(n0 + n) * K + k0 + 8 * c) = o; }
    LDS_WAIT(); asm volatile("" ::: "memory");
    return sq;
}
__device__ __forceinline__ void p0_prologue(Frame& F) {
    int tid_ = threadIdx.x; asm volatile("" : "+v"(tid_)); const int f_tid = tid_, f_lane = tid_ & 63, f_wave = __builtin_amdgcn_readfirstlane(tid_ >> 6);
    if (blockIdx.x == 0 && f_tid < 96) {
        const int i = f_tid < 64 ? f_tid : f_tid - 64; const double r = f_tid < 64 ? 0.8659643233600653 : 0.7498942093324559;
        double v = 0.15915494309189535; for (int j = 0; j < i; ++j) v *= r;
        const float h = (float)v; float* tab = (float*)(F.ws + WS_TAB); tab[2 * f_tid] = h; tab[2 * f_tid + 1] = (float)(v - (double)h);
    }
    {
        LAS float* cs = (LAS float*)(F.lds + RING_OFF); LAS float* part = cs + NB * DM;
        const float* cin = KIN_F(I_C);
        { float cv[NB * DM / (NWAVES * 64)];
#pragma unroll
          for (int j = 0; j < NB * DM / (NWAVES * 64); ++j) cv[j] = cin[f_tid + j * (NWAVES * 64)];
#pragma unroll
          for (int j = 0; j < NB * DM / (NWAVES * 64); ++j) { const float v = cv[j]; cs[f_tid + j * (NWAVES * 64)] = v / (1.f + __expf(-v)); } }
        __syncthreads();
        float* mod = (float*)(F.ws + WS_MOD); const float* ada_w = KIN_F(I_ADAW); const float* ada_b = KIN_F(I_ADAB);
        const int cg = f_tid & 7, kg = f_tid >> 3;
        for (int u = F.vcu; u < 768; u += F.G) {
            const int l = u / 384, cb = (u % 384) * 32;
            f32x4 acc[NB];
#pragma unroll
            for (int b = 0; b < NB; ++b) acc[b] = (f32x4){0.f, 0.f, 0.f, 0.f};
            const float bias_ = f_tid < 256 ? ada_b[l * 12288 + cb + (f_tid & 31)] : 0.f;
            const float* wp = ada_w + (size_t)l * DM * 12288 + cb + 4 * cg;
#pragma unroll 8
            for (int k = kg; k < DM; k += 64) { const f32x4 w = *(const f32x4*)(wp + (size_t)k * 12288);
#pragma unroll
                for (int b = 0; b < NB; ++b) acc[b] += w * cs[b * DM + k]; }
#pragma unroll
            for (int b = 0; b < NB; ++b)
#pragma unroll
                for (int e = 0; e < 4; ++e) { float v = acc[b][e]; v += __shfl_xor(v, 8); v += __shfl_xor(v, 16); v += __shfl_xor(v, 32); acc[b][e] = v; }
            if (f_lane < 8) {
#pragma unroll
                for (int b = 0; b < NB; ++b) *(LAS f32x4*)(part + (f_wave * NB + b) * 32 + 4 * cg) = acc[b]; }
            __syncthreads();
            if (f_tid < 256) { const int b = f_tid >> 5, col = f_tid & 31; float s = bias_;
#pragma unroll
                for (int w = 0; w < NWAVES; ++w) s += part[(w * NB + b) * 32 + col];
                mod[((size_t)l * NB + b) * 12288 + cb + col] = s; }
            __syncthreads();
        }
    }
    LAS float* scr = (LAS float*)(F.lds + RING_OFF + f_wave * 16384);
    const int gw = F.vcu * NWAVES + f_wave, NGW = F.G * NWAVES;
    constexpr int I_IN0 = 32 * (N_IN0 / 32), I_OUT = 32 * (DM / 32), I_1 = 32 * (FF / 32), I_2 = (FF / 64) * (DM / 32), I_IN1 = 32 * (N_IN1 / 32);
    constexpr int NITEMS = I_IN0 + I_IN1 + 2 * (I_OUT + I_1 + I_2);
    for (int it = gw; it < NITEMS; it += NGW) {
        int r = it;
        if (r < I_IN0) { if (!IN0_I8) p0_transpose_item(KIN_F(I_WIN0), DM, W0SRC, N_IN0, (bf16*)(F.ws + WS_WIN0), 1, scr, r, f_lane); continue; } r -= I_IN0;
        if (r < I_IN1) { if (!IN1_I8 || (r % (N_IN1 / 32)) >= N_QKV1 / 32) p0_transpose_item(KIN_F(I_WIN1), DM, W1SRC, N_IN1, (bf16*)(F.ws + WS_WIN1), 2, scr, r, f_lane); continue; } r -= I_IN1;
        if (r < I_OUT) { p0_transpose_item(KIN_F(I_WOUT), DM, DM, DM, (bf16*)(F.ws + WS_WOUT0), 0, scr, r, f_lane); continue; } r -= I_OUT;
        if (r < I_OUT) { if (L1_I8 < 3) p0_transpose_item(KIN_F(I_WOUT) + (size_t)DM * DM, DM, DM, DM, (bf16*)(F.ws + WS_WOUT1), 0, scr, r, f_lane); continue; } r -= I_OUT;
        if (r < I_1) { if (!L0_I8) p0_transpose_item(KIN_F(I_W1), DM, FF, FF, (bf16*)(F.ws + WS_W1_0), 0, scr, r, f_lane); continue; } r -= I_1;
        if (r < I_1) { if (!L1_I8) p0_transpose_item(KIN_F(I_W1) + (size_t)DM * FF, DM, FF, FF, (bf16*)(F.ws + WS_W1_1), 0, scr, r, f_lane); continue; } r -= I_1;
        if (r < I_2) { if (L0_I8 < 2) p0_transpose_item(KIN_F(I_W2), FF, DM, DM, (bf16*)(F.ws + WS_W2_0), 0, scr, r, f_lane); continue; } r -= I_2;
        if (L1_I8 < 2) p0_transpose_item<(FFN2_FP8 != 0) ? 1 : 0>(KIN_F(I_W2) + (size_t)FF * DM, FF, DM, DM, (bf16*)(F.ws + WS_W2_1), 0, scr, r, f_lane);
    }
#define WQ_EN(t) ((t) < 3 ? (L1_I8 > (t)) : (t) < 5 ? (L0_I8 > (t) - 3) : (t) == 5 ? (IN0_I8 != 0) : (IN1_I8 != 0))
#define WQ_SRC(t) ((t) == 0 ? KIN_F(I_W1) + (size_t)DM * FF : (t) == 1 ? KIN_F(I_W2) + (size_t)DM * FF : (t) == 2 ? KIN_F(I_WOUT) + (size_t)DM * DM : (t) == 3 ? KIN_F(I_W1) : (t) == 4 ? KIN_F(I_W2) : (t) == 5 ? KIN_F(I_WIN0) : KIN_F(I_WIN1))
    if (WQ_SIGMA) {
        for (int sl = F.vcu; sl < 256; sl += F.G) { f32x4 v[7][2]; float ss[7];
#pragma unroll
            for (int t = 0; t < 7; ++t) if (WQ_EN(t)) { const f32x4* w = (const f32x4*)WQ_SRC(t); v[t][0] = w[sl * 1024 + f_tid]; v[t][1] = w[sl * 1024 + f_tid + 512]; }
#pragma unroll
            for (int t = 0; t < 7; ++t) if (WQ_EN(t)) { float a = 0.f;
#pragma unroll
                for (int j = 0; j < 2; ++j) a += (v[t][j].x * v[t][j].x + v[t][j].y * v[t][j].y) + (v[t][j].z * v[t][j].z + v[t][j].w * v[t][j].w);
#pragma unroll
                for (int o = 1; o < 64; o <<= 1) a += __shfl_xor(a, o);
                ss[t] = a; }
            __syncthreads();
            if (f_lane == 0) {
#pragma unroll
                for (int t = 0; t < 7; ++t) if (WQ_EN(t)) F.MISC[32 + 8 * t + f_wave] = __builtin_bit_cast(unsigned, ss[t]); }
            __syncthreads();
            if (f_tid < 7 && WQ_EN(f_tid)) { float tot = 0.f;
#pragma unroll
                for (int w8 = 0; w8 < NWAVES; ++w8) tot += __builtin_bit_cast(float, (unsigned)F.MISC[32 + 8 * f_tid + w8]);
                ((float*)(F.ws + WS_SIG))[f_tid * 256 + sl] = tot; } }
        return; }
#pragma unroll 1
    for (int t = 0; t < 7; ++t) { if (t < 3 ? (L1_I8 <= t) : t < 5 ? (L0_I8 <= t - 3) : t == 5 ? !IN0_I8 : !IN1_I8) continue;
        const f32x4* w = (const f32x4*)(t == 0 ? KIN_F(I_W1) + (size_t)DM * FF : t == 1 ? KIN_F(I_W2) + (size_t)DM * FF : t == 2 ? KIN_F(I_WOUT) + (size_t)DM * DM : t == 3 ? KIN_F(I_W1) : t == 4 ? KIN_F(I_W2) : t == 5 ? KIN_F(I_WIN0) : KIN_F(I_WIN1)); float mx = 0.f;
        if (WQ_SIGMA) {
            for (int sl = F.vcu; sl < 256; sl += F.G) { float ss = 0.f;
#pragma unroll
                for (int j = 0; j < 2; ++j) { const f32x4 v = w[sl * 1024 + f_tid + 512 * j]; ss += (v.x * v.x + v.y * v.y) + (v.z * v.z + v.w * v.w); }
#pragma unroll
                for (int o = 1; o < 64; o <<= 1) ss += __shfl_xor(ss, o);
                __syncthreads();
                if (f_lane == 0) F.MISC[32 + f_wave] = __builtin_bit_cast(unsigned, ss);
                __syncthreads();
                if (f_tid == 0) { float tot = 0.f;
#pragma unroll
                    for (int w8 = 0; w8 < NWAVES; ++w8) tot += __builtin_bit_cast(float, (unsigned)F.MISC[32 + w8]);
                    ((float*)(F.ws + WS_SIG))[t * 256 + sl] = tot; } }
            continue; }
        const unsigned n4 = (unsigned)((t == 2 ? (size_t)DM * DM : (size_t)DM * FF) / 4), stride = (unsigned)F.G * (NWAVES * 64);
#pragma unroll 8
        for (unsigned i = (unsigned)F.vcu * (NWAVES * 64) + f_tid; i < n4; i += stride) { const f32x4 v = w[i]; mx = fmaxf(fmaxf(mx, fmaxf(fabsf(v.x), fabsf(v.y))), fmaxf(fabsf(v.z), fabsf(v.w))); }
#pragma unroll
        for (int o = 1; o < 64; o <<= 1) mx = fmaxf(mx, __shfl_xor(mx, o));
        if (f_lane == 0) (void)__hip_atomic_fetch_max((unsigned*)F.ctl + (t == 0 ? CW_W1MAX : t == 1 ? CW_W2MAX : t == 2 ? CW_WOMAX : t == 3 ? CW_W1MAX0 : CW_W2MAX0), __builtin_bit_cast(unsigned, mx), RLX_AGENT); }
}
__device__ __forceinline__ float wq_scale(Frame& F, int t, int cw_max, int lane) {
    if (WQ_SIGMA) { const float* sg = (const float*)(F.ws + WS_SIG) + t * 256; float v = (sg[lane] + sg[lane + 64]) + (sg[lane + 128] + sg[lane + 192]);
#pragma unroll
        for (int o = 1; o < 64; o <<= 1) v += __shfl_xor(v, o);
        return 127.f / fmaxf(4.f * sqrtf(v * (1.f / 1048576.f)), 1e-30f); }
    const float wmax = __builtin_bit_cast(float, __hip_atomic_load((unsigned*)F.ctl + cw_max, RLX_AGENT)); return 127.f / fmaxf(wmax, 1e-30f);
}
__device__ __forceinline__ float tr64_item(const float* W, int K, int Nsrc, int Ndst, unsigned char* WT, int kind, LAS unsigned char* scr, int item, int lane, float qs) {
    const int nblk = Ndst / 64, kb = item / nblk, nb = item % nblk, k0 = 64 * kb, n0 = 64 * nb;
    const int sc0 = (kind == 1 && n0 >= 3072) ? n0 + 8 : n0;
    const int kg = lane >> 4, ng = lane & 15;
    const float* src = W + (size_t)(k0 + 4 * kg) * Nsrc + sc0 + 4 * ng;
    f32x4 tv[4][4];
#pragma unroll
    for (int p = 0; p < 4; ++p)
#pragma unroll
        for (int i = 0; i < 4; ++i) tv[p][i] = *(const f32x4*)(src + (size_t)(16 * p + i) * Nsrc);
    float sq = 0.f;
#pragma unroll
    for (int p = 0; p < 4; ++p) { unsigned r[4];
#pragma unroll
        for (int i = 0; i < 4; ++i) r[i] = pk_i8x4s(tv[p][i].x, tv[p][i].y, tv[p][i].z, tv[p][i].w, qs, sq);
        const unsigned a = __builtin_amdgcn_perm(r[1], r[0], 0x05010400u), b = __builtin_amdgcn_perm(r[1], r[0], 0x07030602u);
        const unsigned c = __builtin_amdgcn_perm(r[3], r[2], 0x05010400u), d = __builtin_amdgcn_perm(r[3], r[2], 0x07030602u);
        const unsigned t0 = __builtin_amdgcn_perm(c, a, 0x05040100u), t1 = __builtin_amdgcn_perm(c, a, 0x07060302u), t2 = __builtin_amdgcn_perm(d, b, 0x05040100u), t3 = __builtin_amdgcn_perm(d, b, 0x07060302u);
        LAS unsigned char* wp = scr + (4 * ng) * 68 + 16 * p + 4 * kg;
        *(LAS unsigned*)(wp) = t0; *(LAS unsigned*)(wp + 68) = t1; *(LAS unsigned*)(wp + 136) = t2; *(LAS unsigned*)(wp + 204) = t3; }
    LDS_WAIT(); asm volatile("" ::: "memory");
    const int pc = lane & 3;
#pragma unroll
    for (int q = 0; q < 4; ++q) { const int n = (lane >> 2) + 16 * q; const LAS unsigned* rp = (const LAS unsigned*)(scr + n * 68 + 16 * pc);
        v4u o; o.x = rp[0]; o.y = rp[1]; o.z = rp[2]; o.w = rp[3];
        *(GAS v4u*)(WT + (size_t)(n0 + n) * K + k0 + 16 * pc) = o; }
    LDS_WAIT(); asm volatile("" ::: "memory");
    return sq;
}
__device__ __forceinline__ void p1_sq_store(Frame& F, float sq, int l, int lane, int wave) {
    unsigned isq = (unsigned)sq;
#pragma unroll
    for (int o = 1; o < 64; o <<= 1) isq += (unsigned)__shfl_xor((int)isq, o);
    __syncthreads();
    if (lane == 0) F.MISC[32 + wave] = isq;
    __syncthreads();
    if (threadIdx.x == 0) { unsigned tot = 0u;
#pragma unroll
        for (int w8 = 0; w8 < NWAVES; ++w8) tot += F.MISC[32 + w8];
        ((unsigned*)(F.ws + WS_SQP))[l * 256 + F.vcu] = tot; }
}
__device__ __forceinline__ void p1_w_int8(Frame& F) {
    int tid_ = threadIdx.x; asm volatile("" : "+v"(tid_)); const int f_lane = tid_ & 63, f_wave = __builtin_amdgcn_readfirstlane(tid_ >> 6);
    __syncthreads();
    LAS float* scr = (LAS float*)(F.lds + RING_OFF + f_wave * 16384); LAS unsigned char* scr8 = (LAS unsigned char*)scr;
    const int gw = F.vcu * NWAVES + f_wave, NGW = F.G * NWAVES;
    float qsv[7];
    { const int cwm[7] = {CW_W1MAX, CW_W2MAX, CW_WOMAX, CW_W1MAX0, CW_W2MAX0, CW_WOMAX, CW_WOMAX};
#pragma unroll
      for (int t = 0; t < 7; ++t) qsv[t] = WQ_EN(t) ? wq_scale(F, t, cwm[t], f_lane) : 1.f; }
    { const float qs = qsv[0];
      float sq = 0.f;
      for (int it = gw; it < (DM / 64) * (FF / 64); it += NGW) sq += tr64_item(KIN_F(I_W1) + (size_t)DM * FF, DM, FF, FF, F.ws + WS_W1_1, 0, scr8, it, f_lane, qs);
      p1_sq_store(F, sq, 1, f_lane, f_wave); }
    if (L1_I8 >= 2) { const float qs = qsv[1];
      for (int it = gw; it < (FF / 64) * (DM / 64); it += NGW) (void)tr64_item(KIN_F(I_W2) + (size_t)FF * DM, FF, DM, DM, F.ws + WS_W2_1, 0, scr8, it, f_lane, qs); }
    if (L0_I8) { const float qs = qsv[3];
      float sq = 0.f;
      for (int it = gw; it < (DM / 64) * (FF / 64); it += NGW) sq += tr64_item(KIN_F(I_W1), DM, FF, FF, F.ws + WS_W1_0, 0, scr8, it, f_lane, qs);
      p1_sq_store(F, sq, 0, f_lane, f_wave); }
    if (L0_I8 >= 2) { const float qs = qsv[4];
      for (int it = gw; it < (FF / 64) * (DM / 64); it += NGW) (void)tr64_item(KIN_F(I_W2), FF, DM, DM, F.ws + WS_W2_0, 0, scr8, it, f_lane, qs); }
    if (IN0_I8) { const float qs = qsv[5];
      for (int it = gw; it < (DM / 64) * (N_IN0 / 64); it += NGW) (void)tr64_item(KIN_F(I_WIN0), DM, W0SRC, N_IN0, F.ws + WS_WIN0, 1, scr8, it, f_lane, qs);
      if (F.vcu == 0 && tid_ == 0) *(float*)(F.ws + WS_WINV) = 1.f / qs; }
    if (IN1_I8) { const float qs = qsv[6];
      for (int it = gw; it < 32 * (N_QKV1 / 32); it += NGW) (void)p0_transpose_item<2>(KIN_F(I_WIN1), DM, W1SRC, N_QKV1, (bf16*)(F.ws + WS_WIN1Q), 2, scr, it, f_lane, qs);
      if (F.vcu == 0 && tid_ == 0) ((float*)(F.ws + WS_WINV))[1] = 1.f / qs; }
    if (L1_I8 >= 3) { const float qs = qsv[2];
      for (int it = gw; it < (DM / 64) * (DM / 64); it += NGW) (void)tr64_item(KIN_F(I_WOUT) + (size_t)DM * DM, DM, DM, DM, F.ws + WS_WOUT1, 0, scr8, it, f_lane, qs); }
}
__device__ __forceinline__ void p2_colsum(Frame& F, const unsigned char* Wq, int* cs) {
    int tid_ = threadIdx.x; asm volatile("" : "+v"(tid_)); const int f_lane = tid_ & 63, f_wave = __builtin_amdgcn_readfirstlane(tid_ >> 6);
    for (int n = F.vcu * NWAVES + f_wave; n < DM; n += F.G * NWAVES) {
        const v4u* rowp = (const v4u*)(Wq + (size_t)n * FF); int sum = 0;
#pragma unroll
        for (int i = 0; i < FF / 1024; ++i) { const v4u x = rowp[f_lane + 64 * i];
#pragma unroll
            for (int e = 0; e < 4; ++e) { const int w = (int)x[e]; sum += ((w << 24) >> 24) + ((w << 16) >> 24) + ((w << 8) >> 24) + (w >> 24); } }
#pragma unroll
        for (int o = 1; o < 64; o <<= 1) sum += __shfl_xor(sum, o);
        if (f_lane == 0) cs[n] = sum;
    }
}
__device__ __forceinline__ float half_max(float v) {
#pragma unroll
    for (int o = 1; o < 32; o <<= 1) v = fmaxf(v, __shfl_xor(v, o));
    return v;
}
template <bool HAS_Y, bool HAS_NEXT, bool FG, int H8 = 0, int XI = 0, int XO = 0>
__device__ __forceinline__ void thin_phase(Frame& F, const float* xin, const bf16* y, float* xout, bf16* hout,
                                           const float* gate, const float* gainY, const float* gainN, const float* scN, const float* shN, int sqw = 0, unsigned char* h8alt = nullptr) {
    int tid_ = threadIdx.x; asm volatile("" : "+v"(tid_)); const int f_tid = tid_, f_lane = tid_ & 63, f_wave = __builtin_amdgcn_readfirstlane(tid_ >> 6);
    LAS float* vA = (LAS float*)(F.lds + RING_OFF); LAS float* vB = vA + DM; LAS float* vC = vB + DM; LAS float* Wfg = vC + DM; LAS float* lf = Wfg + 8 * DM;
    bool first = true;
    float mwq2 = 0.f;
    if (H8 == 2) { const unsigned* sp = (const unsigned*)(F.ws + WS_SQP) + sqw * 256; float v = 0.f;
        for (int i = f_lane; i < F.G; i += 64) v += (float)sp[i];
#pragma unroll
        for (int o = 1; o < 64; o <<= 1) v += __shfl_xor(v, o);
        mwq2 = v * (1.f / ((float)DM * (float)FF)); }
    for (int u = F.vcu; u < MTOK / 128; u += F.G) {
        const int r0 = 128 * u, b = r0 / SEQ;
        __syncthreads();
        for (int c = f_tid; c < DM; c += NWAVES * 64) {
            if (HAS_Y) vA[c] = gate[(size_t)b * 12288 + c] * gainY[c];
            if (HAS_NEXT) { vB[c] = gainN[c] * (1.f + scN[(size_t)b * 12288 + c]); vC[c] = shN[(size_t)b * 12288 + c]; } }
        if (FG && first) { const float* w0 = KIN_F(I_WIN0); float wv[32];
            int ft = f_tid; asm volatile("" : "+v"(ft));
#pragma unroll
            for (int q = 0; q < 32; ++q) { const int i = ft + q * (NWAVES * 64); wv[q] = w0[(size_t)(i >> 3) * W0SRC + 3072 + (i & 7)]; }
#pragma unroll
            for (int q = 0; q < 32; ++q) { const int i = ft + q * (NWAVES * 64); Wfg[(i & 7) * DM + (i >> 3)] = wv[q]; } }
        first = false;
        __syncthreads();
        const int hrow = f_lane >> 5, q_ = f_lane & 31;
#pragma unroll 1
        for (int i = 0; i < 16; i += 2) {
            int q = q_; if (FG && H8) asm volatile("" : "+v"(q));
            const int rl = f_wave * 16 + i + hrow; const size_t row = (size_t)(r0 + rl);
            f32x4 xv[16];
#pragma unroll
            for (int k = 0; k < 16; ++k) {
                if (XI) { const v2u w = __builtin_nontemporal_load((const v2u*)((const bf16*)xin + row * DM + 4 * q + 128 * k)); xv[k] = (f32x4){bflo(w.x), bfhi(w.x), bflo(w.y), bfhi(w.y)}; }
                else xv[k] = __builtin_nontemporal_load((const f32x4*)(xin + row * DM + 4 * q + 128 * k)); }
            if (HAS_Y) {
                v2u yw[16];
#pragma unroll
                for (int k = 0; k < 16; ++k) yw[k] = __builtin_nontemporal_load((const v2u*)(y + YBLK(row, 4 * q + 128 * k)));
                float ss = 0.f;
#pragma unroll
                for (int k = 0; k < 16; ++k) { const float a0 = bflo(yw[k].x), a1 = bfhi(yw[k].x), a2 = bflo(yw[k].y), a3 = bfhi(yw[k].y); ss += (a0 * a0 + a1 * a1) + (a2 * a2 + a3 * a3); }
                const float ry = 1.f / sqrtf(half_sum(ss) * (1.f / DM) + RMS_EPS);
#pragma unroll
                for (int k = 0; k < 16; ++k) { const f32x4 a = *(const LAS f32x4*)(vA + 4 * q + 128 * k); const f32x4 yv = (f32x4){bflo(yw[k].x), bfhi(yw[k].x), bflo(yw[k].y), bfhi(yw[k].y)};
                    xv[k] += a * yv * ry;
                    if (XO) { v2u w; w.x = pk2(xv[k].x, xv[k].y); w.y = pk2(xv[k].z, xv[k].w); __builtin_nontemporal_store(w, (v2u*)((bf16*)xout + row * DM + 4 * q + 128 * k)); }
                    else __builtin_nontemporal_store(xv[k], (f32x4*)(xout + row * DM + 4 * q + 128 * k)); }
            }
            if (HAS_NEXT) {
                float ss = 0.f;
#pragma unroll
                for (int k = 0; k < 16; ++k) ss += (xv[k].x * xv[k].x + xv[k].y * xv[k].y) + (xv[k].z * xv[k].z + xv[k].w * xv[k].w);
                const float rx = 1.f / sqrtf(half_sum(ss) * (1.f / DM) + RMS_EPS);
                float fa[8];
#pragma unroll
                for (int h = 0; h < 8; ++h) fa[h] = 0.f;
                if (H8) { float mx = 0.f, s2 = 0.f;
#pragma unroll
                    for (int k = 0; k < 16; ++k) { const f32x4 bb = *(const LAS f32x4*)(vB + 4 * q + 128 * k), cc = *(const LAS f32x4*)(vC + 4 * q + 128 * k);
                        const f32x4 hv = xv[k] * rx * bb + cc; xv[k] = hv; mx = fmaxf(fmaxf(mx, fmaxf(fabsf(hv.x), fabsf(hv.y))), fmaxf(fabsf(hv.z), fabsf(hv.w))); s2 += (hv.x * hv.x + hv.y * hv.y) + (hv.z * hv.z + hv.w * hv.w);
                        if (H8 == 4) { v2u w; w.x = pk2(hv.x, hv.y); w.y = pk2(hv.z, hv.w); *(v2u*)(hout + row * DM + 4 * q + 128 * k) = w; }
                        if ((k & 3) == 3) __builtin_amdgcn_sched_barrier(0); }
                    const float hmx = fmaxf(half_max(mx), 1e-30f); const float qs = 127.f / hmx;
                    if ((H8 == 3 || H8 == 4) && q == 0) ((float*)(F.ws + WS_RINV))[row] = hmx * (1.f / 127.f);
                    if (H8 == 2) {
                        s2 = half_sum(s2);
                        if (q == 0) ((float*)(F.ws + WS_ROWS))[row] = (HID_U8 ? 255.f / 20.f : 127.f / 16.f) / fmaxf(qs * qs * s2 * mwq2, 1e-30f); }
#pragma unroll
                    for (int k = 0; k < 16; ++k) *(unsigned*)((H8 == 4 ? h8alt : (unsigned char*)hout) + row * DM + 4 * q + 128 * k) = pk_i8x4(xv[k].x, xv[k].y, xv[k].z, xv[k].w, qs);
                    if (FG) {
                        typedef float f32x2_ __attribute__((ext_vector_type(2)));
                        f32x2_ fa2[8]; f32x4 wc[8];
#pragma unroll
                        for (int h = 0; h < 8; ++h) { fa2[h] = (f32x2_){0.f, 0.f}; wc[h] = *(const LAS f32x4*)(Wfg + h * DM + 4 * q); }
#pragma unroll
                        for (int k = 0; k < 16; ++k) { f32x4 wn[8];
                            if (k + 1 < 16) {
#pragma unroll
                                for (int h = 0; h < 8; ++h) wn[h] = *(const LAS f32x4*)(Wfg + h * DM + 4 * q + 128 * (k + 1)); }
                            const f32x4 hv = xv[k]; const f32x2_ h01 = {hv.x, hv.y}, h23 = {hv.z, hv.w};
#pragma unroll
                            for (int h = 0; h < 8; ++h) { fa2[h] += h01 * (f32x2_){wc[h].x, wc[h].y}; fa2[h] += h23 * (f32x2_){wc[h].z, wc[h].w}; }
                            if (k + 1 < 16) {
#pragma unroll
                                for (int h = 0; h < 8; ++h) wc[h] = wn[h]; }
                            __builtin_amdgcn_sched_barrier(0); }
#pragma unroll
                        for (int h = 0; h < 8; ++h) fa[h] = fa2[h].x + fa2[h].y; }
                } else
#pragma unroll
                for (int k = 0; k < 16; ++k) { const f32x4 bb = *(const LAS f32x4*)(vB + 4 * q + 128 * k), cc = *(const LAS f32x4*)(vC + 4 * q + 128 * k);
                    const f32x4 hv = xv[k] * rx * bb + cc;
                    v2u w; w.x = pk2(hv.x, hv.y); w.y = pk2(hv.z, hv.w); *(v2u*)(hout + row * DM + 4 * q + 128 * k) = w;
                    if (FG) {
#pragma unroll
                        for (int h = 0; h < 8; ++h) { const f32x4 ww = *(const LAS f32x4*)(Wfg + h * DM + 4 * q + 128 * k); fa[h] += (hv.x * ww.x + hv.y * ww.y) + (hv.z * ww.z + hv.w * ww.w); } } }
                if (FG) {
#pragma unroll
                    for (int h = 0; h < 8; ++h) fa[h] = half_sum(fa[h]);
                    if (q < 8) { float v = 0.f;
#pragma unroll
                        for (int h = 0; h < 8; ++h) v = (q == h) ? fa[h] : v;
                        v += KIN_F(I_BF)[q];
                        lf[rl * 8 + q] = fminf(v, 0.f) - __logf(1.f + __expf(-fabsf(v))); }
                }
            }
        }
        if (FG) {
            __syncthreads();
            if (f_tid < 64) { const int h = f_tid & 7, part = f_tid >> 3; float run = 0.f; float loc[16];
#pragma unroll
                for (int i = 0; i < 16; ++i) { run += lf[(part * 16 + i) * 8 + h]; loc[i] = run; }
                float pre = 0.f;
#pragma unroll
                for (int pp = 0; pp < 8; ++pp) { const float t = __shfl(run, pp * 8 + h); if (pp < part) pre += t; }
                float* Floc = (float*)(F.ws + WS_FLOC) + ((size_t)(b * 8 + h) * SEQ + (r0 % SEQ) + part * 16);
#pragma unroll
                for (int i = 0; i < 16; ++i) Floc[i] = pre + loc[i];
                if (part == 7) ((float*)(F.ws + WS_BTOT))[(b * 8 + h) * 32 + (r0 % SEQ) / 128] = pre + run; }
        }
    }
}
__device__ __forceinline__ void mixer0_phase(Frame& F, char* lds) {
    int tid_ = threadIdx.x; asm volatile("" : "+v"(tid_)); const int f_tid = tid_, f_lane = tid_ & 63, f_wave = __builtin_amdgcn_readfirstlane(tid_ >> 6);
    using att::BlockRef; using att::Seam; using att::TIN; using att::TOUT; using att::QB; using att::LDQ; using att::LDO; using att::SKV; using att::WINDOW;
    const ::bf16* proj = (const ::bf16*)(F.ws + WS_PROJ); ::bf16* o = (::bf16*)(F.ws + WS_O);
    const float* Floc = (const float*)(F.ws + WS_FLOC); const float* Btot = (const float*)(F.ws + WS_BTOT);
    float* fb = (float*)(lds + att::LDS_FB); float* pre = fb + SKV;
#pragma unroll 1
    for (int frep = ((MK_DOUBLE == 503 || MK_DOUBLE == 504) ? 0 : 1); frep < 2; ++frep)
    for (int it = blockIdx.x; it < 256; it += F.G) {
        const int bh = it >> 2, qt = it & 3, b = bh >> 3, h = bh & 7;
        const int qbs[4] = {qt, 7 - qt, 8 + qt, 15 - qt};
        __syncthreads();
        int ft0 = f_tid; asm volatile("" : "+v"(ft0));
        if (ft0 < 64) { const float v = ft0 < 32 ? Btot[bh * 32 + ft0] : 0.f; float inc = v;
#pragma unroll
            for (int o = 1; o < 32; o <<= 1) { const float t = __shfl_up(inc, o); if (ft0 >= o) inc += t; }
            if (ft0 < 32) pre[ft0] = inc - v; if (ft0 == 31) pre[32] = inc; }
        const __hip_bfloat16* base = (const __hip_bfloat16*)proj + (size_t)b * SEQ * LDQ + (size_t)(h * 4) * 512;
        int Wfox = WINDOW; float qa0 = 0.f, qd0 = 0.f, qa1 = 0.f, qd1 = 0.f;
        if (FOX_WIN) {
            typedef _Float16 h2_ __attribute__((ext_vector_type(2)));
            float kk = 0.f; int ft = f_tid; asm volatile("" : "+v"(ft));
#pragma unroll 4
            for (int i = 0; i < 8; ++i) { const int r = ft + 512 * i;
                const __hip_bfloat16* rp = base + 32 * 512 + (size_t)(r >> 4) * (LDQ / 32) * 512 + (r & 15) * 32; float ssq = 0.f;
#pragma unroll
                for (int cb = 0; cb < 4; ++cb)
#pragma unroll
                    for (int e = 0; e < 4; ++e) { const v4u x = *(const v4u*)(rp + cb * 512 + e * 8);
#pragma unroll
                        for (int w = 0; w < 4; ++w) { const h2_ hh = __builtin_bit_cast(h2_, x[w]); ssq = __builtin_amdgcn_fdot2(hh, hh, ssq, false); } }
                kk = fmaxf(kk, ssq); }
#pragma unroll 1
            for (int i = 0; i < 2; ++i) { const int qi_ = 2 * i + (ft >> 8); const int qb_ = qi_ == 0 ? qt : qi_ == 1 ? 7 - qt : qi_ == 2 ? 8 + qt : 15 - qt;
                const int r = qb_ * QB + (ft & 255);
                const __hip_bfloat16* rp = base + (size_t)(r >> 4) * (LDQ / 32) * 512 + (r & 15) * 32; float ssq = 0.f, dqk = 0.f;
#pragma unroll
                for (int cb = 0; cb < 4; ++cb)
#pragma unroll
                    for (int e = 0; e < 4; ++e) { const v4u x = *(const v4u*)(rp + cb * 512 + e * 8), y = *(const v4u*)(rp + 32 * 512 + cb * 512 + e * 8);
#pragma unroll
                        for (int w = 0; w < 4; ++w) { const h2_ hq = __builtin_bit_cast(h2_, x[w]), hk = __builtin_bit_cast(h2_, y[w]); ssq = __builtin_amdgcn_fdot2(hq, hq, ssq, false); dqk = __builtin_amdgcn_fdot2(hq, hk, dqk, false); } }
                if (i == 0) { qa0 = ssq; qd0 = dqk; } else { qa1 = ssq; qd1 = dqk; } }
#pragma unroll
            for (int o = 1; o < 64; o <<= 1) kk = fmaxf(kk, __shfl_xor(kk, o));
            if ((ft & 63) == 0) pre[40 + (ft >> 6)] = kk;
        }
        __syncthreads();
        for (int s = f_tid; s < SKV; s += NWAVES * 64) fb[s] = -(Floc[(size_t)bh * SEQ + s] + pre[s >> 7]) * 11.313708498984761f;
        if (FOX_WIN) { int ftq = f_tid; asm volatile("" : "+v"(ftq)); float km = 0.f;
#pragma unroll
            for (int w = 0; w < NWAVES; ++w) km = fmaxf(km, pre[40 + w]);
            float tq = fmaxf(sqrtf(qa0 * km) - qd0, sqrtf(qa1 * km) - qd1);
#pragma unroll
            for (int o = 1; o < 64; o <<= 1) tq = fmaxf(tq, __shfl_xor(tq, o));
            if ((ftq & 63) == 0) pre[48 + (ftq >> 6)] = tq;
            __syncthreads(); }
        if (FOX_WIN) {
            int ft2 = f_tid; asm volatile("" : "+v"(ft2));
            if (ft2 < 64) { float tm = -3.0e38f;
#pragma unroll
                for (int w = 0; w < NWAVES; ++w) tm = fmaxf(tm, pre[48 + w]);
                const float T = tm * 0.08838834764831845f + 30.f;
                const int n = ft2 + 1; float Dn = -3.0e38f;
                if (n <= 32) { for (int j = 0; j + n <= 32; ++j) Dn = fmaxf(Dn, pre[j + n] - pre[j]); }
                const unsigned long long ok = __ballot(n <= 32 && Dn <= -T);
                int W = SKV; if (ok) { const int n0 = __builtin_ctzll(ok) + 1; W = 128 * (n0 + 1); if (W > SKV) W = SKV; }
                if (ft2 == 0) ((volatile int*)pre)[56] = W; }
            __syncthreads();
            Wfox = __builtin_amdgcn_readfirstlane(((volatile int*)pre)[56]);
        }
        __hip_bfloat16* obase = (__hip_bfloat16*)o + (size_t)b * SEQ * LDO + h * 128;
#define FOX_REF(qb) BlockRef<TIN, TOUT>{base + (size_t)(qb) * QB * LDQ, base + 32 * 512, base + 64 * 512, obase + (size_t)(qb) * QB * LDO, (qb) * QB}
        BlockRef<TIN, TOUT> cur = FOX_REF(qbs[0]);
        Seam<TIN> S;
        att::causal_swa_prime<TIN, TOUT>(cur, Wfox, lds, S);
#pragma unroll 1
        for (int k = 0; k < 4; ++k) {
            const int qn = qbs[k < 3 ? k + 1 : k];
            const BlockRef<TIN, TOUT> nxt = FOX_REF(qn);
            if (MK_DOUBLE == 503 && frep == 0) att::causal_swa_block<TIN, TOUT, false>(cur, nxt, SKV, Wfox, lds, S, (unsigned)(uintptr_t)fb); else
            att::causal_swa_block<TIN, TOUT>(cur, nxt, SKV, Wfox, lds, S, (unsigned)(uintptr_t)fb);
            cur = nxt;
        }
#undef FOX_REF
    }
    for (int it = blockIdx.x; it < 256; it += F.G) {
        const int bh = it >> 2, qt = it & 3, b = bh >> 3, h = bh & 7;
        const int qbs[4] = {qt, 7 - qt, 8 + qt, 15 - qt};
        const __hip_bfloat16* base = (const __hip_bfloat16*)proj + (size_t)b * SEQ * LDQ + (size_t)(96 + h * 4) * 512;
        __hip_bfloat16* obase = (__hip_bfloat16*)o + (size_t)b * SEQ * LDO + 1024 + h * 128;
#pragma unroll 1
        for (int k = 0; k < 4; ++k) { const int qb = qbs[k];
            __syncthreads();
            att::sb_block(base + (size_t)qb * QB * LDQ, base + 32 * 512, base + 64 * 512, obase + (size_t)qb * QB * LDO, qb * QB, lds, (volatile int*)(lds + LDSCTL_OFF - RING_OFF)); }
    }
}

#if !MK_PER_PHASE
#define GRID_BAR() xcd_barrier(bar)
#else
#define GRID_BAR() do { } while (0)
#endif
#define IN(k) (lo <= (k) && (k) < hi)
#define BOTH(k) (IN(k) && IN((k) + 1))

template <int l>
__device__ __forceinline__ void layer_phases(Frame& F, const XcdBarrier& bar, unsigned char* lds, int lo, int hi) {
    unsigned char* const ws = F.ws;
    bf16* const Hb = (bf16*)(ws + WS_H); bf16* const Yb = (bf16*)(ws + WS_Y); bf16* const PROJ = (bf16*)(ws + WS_PROJ); bf16* const Ob = (bf16*)(ws + WS_O); bf16* const HID = (bf16*)(ws + WS_HID);
    const float* const mod = (const float*)(ws + WS_MOD);

        const int pb = 2 + 7 * l;
        const float* const modl = mod + (size_t)l * NB * 12288;
#define NG_ (KIN_F(I_NORMG) + (size_t)l * 4 * DM)
#define XS_ (X16 ? (float*)(ws + WS_X16) : F.out)
        if (IN(pb)) {
            if constexpr (l == 0 && HID_U8 != 0) { if (L1_I8 >= 2) p2_colsum(F, ws + WS_W2_1, (int*)F.ctl + CW_CS1); if (L0_I8 >= 2) p2_colsum(F, ws + WS_W2_0, (int*)F.ctl + CW_CS0); }
            if constexpr (l == 0) { pg8::Gemm g{Hb, (const bf16*)(ws + WS_WIN0), MTOK, N_IN0, DM}; pg8::StaticOrder S; S.init(MTOK, N_IN0, F.G, (int)blockIdx.x);
                if constexpr (IN0_I8 != 0) { g.K = DM / 2;
                    pg8::EpiBf16<6, true> E{PROJ, N_IN0, 3072, 4096, QSCALE, nullptr, (const float*)(ws + WS_RINV), (const float*)(ws + WS_WINV)};
                    pg8::gemm_phase<pg8::EpiBf16<6, true>, pg8::StaticOrder, PG8_ALIGN, PG8_SP2, false, false, true>(F.lds + RING_OFF, g, S, E); }
                else {
                pg8::EpiBf16<0, true> E{PROJ, N_IN0, 3072, 4096, QSCALE};
#pragma unroll 1
                for (int rep_ = 0; rep_ < ((MK_DOUBLE == pb) ? 2 : 1); ++rep_) { pg8::gemm_phase<pg8::EpiBf16<0, true>, pg8::StaticOrder, PG8_ALIGN, PG8_SP2>(F.lds + RING_OFF, g, S, E); if (MK_DOUBLE == pb && rep_ == 0) GRID_BAR(); } } }
            else if constexpr (IN1_I8 != 0) {
                { pg8::Gemm g{Hb, (const bf16*)(ws + WS_WIN1) + (size_t)N_QKV1 * DM, MTOK, N_IN1 - N_QKV1, DM}; pg8::StaticOrder S; S.init(MTOK, N_IN1 - N_QKV1, F.G, (int)blockIdx.x);
                  pg8::EpiRope E{PROJ, N_IN1, KIN_I(I_POS), (const float*)(ws + WS_TAB), QSCALE, N_QKV1};
                  pg8::gemm_phase<pg8::EpiRope, pg8::StaticOrder, PG8_ALIGN, PG8_SP2>(F.lds + RING_OFF, g, S, E); }
                { pg8::Gemm g{(const bf16*)(ws + WS_H8B), (const bf16*)(ws + WS_WIN1Q), MTOK, N_QKV1, DM / 2}; pg8::DealOrder S; S.init(MTOK, N_QKV1, F.G, (int)blockIdx.x);
                  pg8::EpiRopeT<true> E{PROJ, N_IN1, KIN_I(I_POS), (const float*)(ws + WS_TAB), QSCALE, 0, (const float*)(ws + WS_RINV), (const float*)(ws + WS_WINV) + 1, ws + WS_K8};
                  pg8::gemm_phase<pg8::EpiRopeT<true>, pg8::DealOrder, PG8_ALIGN, PG8_SP2, false, false, true>(F.lds + RING_OFF, g, S, E); } }
            else { pg8::Gemm g{Hb, (const bf16*)(ws + WS_WIN1), MTOK, N_IN1, DM}; pg8::StaticOrder S; S.init(MTOK, N_IN1, F.G, (int)blockIdx.x);
                pg8::EpiRope E{PROJ, N_IN1, KIN_I(I_POS), (const float*)(ws + WS_TAB), QSCALE};
                pg8::gemm_phase<pg8::EpiRope, pg8::StaticOrder, PG8_ALIGN, PG8_SP2>(F.lds + RING_OFF, g, S, E); }
            if (BOTH(pb)) GRID_BAR();
        }
        if (IN(pb + 1)) {
#pragma unroll 1
            for (int rep = 0; rep < ((MK_DOUBLE == pb + 1) ? 2 : 1); ++rep) {
            if constexpr (l == 0) mixer0_phase(F, (char*)lds + RING_OFF);
            else dsa::dsa_phase((LAS char*)(F.lds + RING_OFF), PROJ, (float*)(ws + WS_ISCR), Ob, F.G, (int)blockIdx.x, ws + WS_K8);
            if (BOTH(pb + 1)) GRID_BAR(); }
        }
        if (IN(pb + 2)) {
            pg8::Gemm g{Ob, (const bf16*)(ws + (l == 0 ? WS_WOUT0 : WS_WOUT1)), MTOK, DM, DM}; pg8::StaticOrder S; S.init(MTOK, DM, F.G, (int)blockIdx.x);
            if constexpr (l == 1 && L1_I8 >= 3) { g.K = DM / 2;
                pg8::EpiBf16<4, true> E4{Yb, DM, 0, 0, 1.f};
                pg8::gemm_phase<pg8::EpiBf16<4, true>, pg8::StaticOrder, PG8_ALIGN, PG8_SP2, false, false, true>(F.lds + RING_OFF, g, S, E4);
                if (BOTH(pb + 2)) GRID_BAR(); }
            else {
            pg8::EpiBf16<0, true> E{Yb, DM, 0, 0, 1.f};
#pragma unroll 1
            for (int rep_ = 0; rep_ < ((MK_DOUBLE == pb + 2) ? 2 : 1); ++rep_) {
            pg8::gemm_phase<pg8::EpiBf16<0, true>, pg8::StaticOrder, PG8_ALIGN, PG8_SP2>(F.lds + RING_OFF, g, S, E);
            if (BOTH(pb + 2)) GRID_BAR(); } }
        }
        if (IN(pb + 3)) {
#pragma unroll 1
            for (int rep = 0; rep < ((MK_DOUBLE == pb + 3) ? 2 : 1); ++rep) {
            thin_phase<true, true, false, (l == 1 ? (L1_I8 >= 2 ? 2 : L1_I8 ? 1 : 0) : L0_I8), (X16 && l == 1) ? 1 : 0, X16 ? 1 : 0>(F, l == 0 ? KIN_F(I_X) : XS_, Yb, XS_, Hb, modl + 2 * DM, NG_ + 1 * DM, NG_ + 2 * DM, modl + 4 * DM, modl + 3 * DM, l);
            if (BOTH(pb + 3)) GRID_BAR(); }
        }
        if (IN(pb + 4)) {
            pg8::Gemm g{Hb, (const bf16*)(ws + (l == 0 ? WS_W1_0 : WS_W1_1)), MTOK, FF, DM}; pg8::StaticOrder S; S.init(MTOK, FF, F.G, (int)blockIdx.x);
            if constexpr ((l == 1 && L1_I8 == 1) || (l == 0 && L0_I8 == 1)) { g.K = DM / 2;
                pg8::EpiBf16<2, true> E{HID, FF, 0, 0, 1.f};
#pragma unroll 1
                for (int rep = 0; rep < ((MK_DOUBLE == pb + 4) ? 2 : 1); ++rep) {
                pg8::gemm_phase<pg8::EpiBf16<2, true>, pg8::StaticOrder, PG8_ALIGN, PG8_SP2, false, false, true>(F.lds + RING_OFF, g, S, E);
                if (BOTH(pb + 4)) GRID_BAR(); } }
            else if constexpr ((l == 1 && L1_I8 >= 2) || (l == 0 && L0_I8 >= 2)) { g.K = DM / 2;
                pg8::EpiI8Hid E{(unsigned char*)HID, FF, (const float*)(ws + WS_ROWS)};
#pragma unroll 1
                for (int rep = 0; rep < ((MK_DOUBLE == pb + 4) ? 2 : 1); ++rep) {
                pg8::gemm_phase<pg8::EpiI8Hid, pg8::StaticOrder, PG8_ALIGN, PG8_SP2, false, false, true>(F.lds + RING_OFF, g, S, E);
                if (BOTH(pb + 4)) GRID_BAR(); } }
            else if constexpr (l == 0 || !FFN2_FP8) { pg8::EpiBf16<1, true> E{HID, FF, 0, 0, 1.f};
#pragma unroll 1
                for (int rep = 0; rep < ((MK_DOUBLE == pb + 4) ? 2 : 1); ++rep) {
                pg8::gemm_phase<pg8::EpiBf16<1, true>, pg8::StaticOrder, PG8_ALIGN, PG8_SP2>(F.lds + RING_OFF, g, S, E);
                if (BOTH(pb + 4)) GRID_BAR(); } }
            else { pg8::EpiF8Hid E{(unsigned char*)HID, FF};
                pg8::gemm_phase<pg8::EpiF8Hid, pg8::StaticOrder, PG8_ALIGN, PG8_SP2>(F.lds + RING_OFF, g, S, E);
                if (BOTH(pb + 4)) GRID_BAR(); }
        }
        if (IN(pb + 5)) {
            pg8::StaticOrder S; S.init(MTOK, DM, F.G, (int)blockIdx.x);
            pg8::EpiBf16<0, true> E{Yb, DM, 0, 0, 1.f};
            if constexpr ((l == 1 && L1_I8 >= 2) || (l == 0 && L0_I8 >= 2)) { pg8::Gemm g{HID, (const bf16*)(ws + (l == 0 ? WS_W2_0 : WS_W2_1)), MTOK, DM, FF / 2};
                pg8::EpiBf16<(HID_U8 ? 5 : 4), true> E4{Yb, DM, 0, 0, 1.f, (const int*)F.ctl + (l == 0 ? CW_CS0 : CW_CS1)};
#pragma unroll 1
                for (int rep_ = 0; rep_ < ((MK_DOUBLE == pb + 5) ? 2 : 1); ++rep_) {
                pg8::gemm_phase<pg8::EpiBf16<(HID_U8 ? 5 : 4), true>, pg8::StaticOrder, PG8_ALIGN, PG8_SP2, true, false, true>(F.lds + RING_OFF, g, S, E4);
                if (BOTH(pb + 5)) GRID_BAR(); } }
            else if constexpr (l == 0 || !FFN2_FP8) { pg8::Gemm g{HID, (const bf16*)(ws + (l == 0 ? WS_W2_0 : WS_W2_1)), MTOK, DM, FF};
#pragma unroll 1
                for (int rep_ = 0; rep_ < ((MK_DOUBLE == pb + 5) ? 2 : 1); ++rep_) {
                pg8::gemm_phase<pg8::EpiBf16<0, true>, pg8::StaticOrder, PG8_ALIGN, PG8_SP2, true>(F.lds + RING_OFF, g, S, E);
                if (BOTH(pb + 5)) GRID_BAR(); } }
            else { pg8::Gemm g{HID, (const bf16*)(ws + WS_W2_1), MTOK, DM, FF / 2};
                pg8::gemm_phase<pg8::EpiBf16<0, true>, pg8::StaticOrder, PG8_ALIGN, PG8_SP2, true, true>(F.lds + RING_OFF, g, S, E);
                if (BOTH(pb + 5)) GRID_BAR(); }
        }
        if (IN(pb + 6)) {
            if constexpr (l == 0) thin_phase<true, true, false, (IN1_I8 ? 4 : 0), X16 ? 1 : 0, X16 ? 1 : 0>(F, XS_, Yb, XS_, Hb, modl + 5 * DM, NG_ + 3 * DM, KIN_F(I_NORMG) + 4 * DM, mod + (size_t)NB * 12288 + 1 * DM, mod + (size_t)NB * 12288 + 0 * DM, 0, ws + WS_H8B);
            else thin_phase<true, false, false, 0, X16 ? 1 : 0, 0>(F, XS_, Yb, F.out, nullptr, modl + 5 * DM, NG_ + 3 * DM, nullptr, nullptr, nullptr);
            if (BOTH(pb + 6)) GRID_BAR();
        }

}
__global__ void __launch_bounds__(NWAVES * 64, 2) mk_fwd(Args args) {
    extern __shared__ __attribute__((aligned(16))) unsigned char lds[];
    Frame F;
    F.lds = (LAS unsigned char*)lds;
    F.MISC = (volatile LAS unsigned*)(F.lds + MISC_OFF);
    F.G = gridDim.x; { const int bx = blockIdx.x; F.vcu = (F.G % 8 == 0) ? (bx % 8) * (F.G / 8) + bx / 8 : bx; }
    unsigned char* ws = args.ws; F.ws = ws;
    F.ctl = (gu32*)(ws + WS_CTL);
    F.out = args.out;
    for (int u = threadIdx.x; u < (LDS_BYTES - LDSCTL_OFF) / 4; u += NWAVES * 64) ((LAS unsigned*)(F.lds + LDSCTL_OFF))[u] = 0u;
    __syncthreads();
    XcdBarrier bar; bar.bar = (unsigned*)(F.ctl + CW_BAR); bar.x = 0; bar.st = nullptr;
#if !MK_PER_PHASE
    bar = xcd_barrier_post((unsigned*)(F.ctl + CW_BAR), F.MISC + 8);
#endif
    const int lo = args.ph_lo, hi = args.ph_hi;
    bf16* const Hb = (bf16*)(ws + WS_H); bf16* const Yb = (bf16*)(ws + WS_Y); bf16* const PROJ = (bf16*)(ws + WS_PROJ); bf16* const Ob = (bf16*)(ws + WS_O); bf16* const HID = (bf16*)(ws + WS_HID);
    const float* const mod = (const float*)(ws + WS_MOD);

    if (IN(0)) {
#pragma unroll 1
        for (int rep = 0; rep < ((MK_DOUBLE == 0) ? 2 : 1); ++rep) { p0_prologue(F); if (BOTH(0)) GRID_BAR(); } }
    if (IN(1)) {
#pragma unroll 1
        for (int rep = 0; rep < ((MK_DOUBLE == 1) ? 2 : 1); ++rep) {
        thin_phase<false, true, true, (IN0_I8 ? 3 : 0)>(F, KIN_F(I_X), nullptr, nullptr, Hb, nullptr, nullptr, KIN_F(I_NORMG) + 0 * DM, mod + 1 * DM, mod + 0 * DM);
        if (L1_I8 || L0_I8 || IN0_I8 || IN1_I8) p1_w_int8(F);
#ifdef P1DUP
        p1_w_int8(F);
#endif
        if (BOTH(1)) GRID_BAR(); }
    }
    layer_phases<0>(F, bar, lds, lo, hi);
    layer_phases<1>(F, bar, lds, lo, hi);
}

extern "C" void kernel_launch(void* const* d_in, const int* in_sizes, int n_in, void* d_out, int out_size, void* d_ws, size_t ws_size, hipStream_t stream) {
    static int grid = 0;
    if (grid == 0) {
        if (n_in != 12 || in_sizes[0] != MTOK * DM || out_size != MTOK * DM || ws_size < WS_END) { fprintf(stderr, "kernel_launch: unexpected shapes (n_in %d, in0 %d, out %d, ws %zu < %zu); nothing launched\n", n_in, n_in > 0 ? in_sizes[0] : -1, out_size, ws_size, (size_t)WS_END); grid = -1; return; }
        int dev = 0, cus = 0, per_cu = 0;
        if (hipGetDevice(&dev) != hipSuccess || hipDeviceGetAttribute(&cus, hipDeviceAttributeMultiprocessorCount, dev) != hipSuccess) { grid = -1; return; }
        if (hipFuncSetAttribute((const void*)mk_fwd, hipFuncAttributeMaxDynamicSharedMemorySize, LDS_BYTES) != hipSuccess) { fprintf(stderr, "kernel_launch: hipFuncSetAttribute failed\n"); grid = -1; return; }
        if (hipOccupancyMaxActiveBlocksPerMultiprocessor(&per_cu, (const void*)mk_fwd, NWAVES * 64, LDS_BYTES) != hipSuccess || per_cu < 1) { fprintf(stderr, "kernel_launch: occupancy query reports %d workgroups per CU\n", per_cu); grid = -1; (void)hipGetLastError(); return; }
        (void)hipGetLastError();
        grid = cus;
        if (grid > 256) grid = 256;
    }
    if (grid < 0) return;
    if (hipMemsetAsync((char*)d_ws + WS_CTL, 0, CTL_ZERO_BYTES, stream) != hipSuccess) return;
    Args a{};
    for (int i = 0; i < 12; ++i) a.in[i] = d_in[i];
    a.out = (float*)d_out; a.ws = (unsigned char*)d_ws;
#if MK_PER_PHASE
    for (int ph = 0; ph < N_PHASES; ++ph) { a.ph_lo = ph; a.ph_hi = ph + 1; hipLaunchKernelGGL(mk_fwd, dim3(grid), dim3(NWAVES * 64), LDS_BYTES, stream, a);
#if MK_DIAG
        { DiagIn D{(const float*)d_in[0], (const float*)d_in[1], (const float*)d_in[3], (const float*)d_in[4], (const float*)d_in[5], (const float*)d_in[6], (const float*)d_in[7], (const float*)d_in[8], (const float*)d_in[10], (const float*)d_in[11], (float*)d_out, (unsigned char*)d_ws};
#define DG(w, l, f) hipLaunchKernelGGL(diag_gen, dim3(64), dim3(64), 0, stream, D, w, l, f)
          if (DIAG_SET == 3) { if (ph == 5) DG(10, 0, 0); }
          if (DIAG_SET == 5) { if (ph == 10) hipLaunchKernelGGL(diag_syn, dim3(3), dim3(64), 0, stream, (unsigned char*)d_ws, SYN_A, SYN_B, SYN_C); }
          if (DIAG_SET == 4) { if (ph == 10) hipLaunchKernelGGL(diag_rows, dim3(64), dim3(64), 0, stream, (unsigned char*)d_ws, 2); }
          if (DIAG_SET == 0) { if (ph == 0) DG(1, 0, 0); if (ph == 1) { DG(2, 0, 1); DG(3, 0, 2); } }
          if (DIAG_SET == 1) { if (ph == 2) DG(4, 0, 0); if (ph == 4) DG(5, 0, 1); if (ph == 11) DG(5, 1, 1); if (ph == 5) DG(6, 0, 2); if (ph == 12) DG(6, 1, 2); }
          if (DIAG_SET == 2) { if (ph == 6) DG(7, 0, 0); if (ph == 13) DG(7, 1, 0); if (ph == 7) DG(8, 0, 1); if (ph == 14) DG(8, 1, 1); if (ph == 8) DG(9, 0, 2); }
        }
#endif
    }
#if MK_DIAG
    hipLaunchKernelGGL(diag_apply, dim3(1), dim3(64), 0, stream, (unsigned char*)d_ws, (float*)d_out);
#endif
#else
    a.ph_lo = 0; a.ph_hi = N_PHASES; hipLaunchKernelGGL(mk_fwd, dim3(grid), dim3(NWAVES * 64), LDS_BYTES, stream, a);
#endif
}
```

```cpp
#include <hip/hip_runtime.h>
#include <hip/hip_bf16.h>
#include <cstdio>
#include <cstdint>
#ifndef MK_PER_PHASE
#define MK_PER_PHASE 0
#endif
#ifndef MK_DIAG
#define MK_DIAG 0
#endif
#ifndef DIAG_SET
#define DIAG_SET 0
#endif
#ifndef SYN_A
#define SYN_A 0
#define SYN_B 5
#define SYN_C 12
#endif
#ifndef MK_DOUBLE
#define MK_DOUBLE (-1)
#endif
#ifndef DSA_DUP
#define DSA_DUP 0
#endif
#ifndef PG8_ALIGN
#define PG8_ALIGN true
#endif
#ifndef PG8_SP2
#define PG8_SP2 true
#endif
#ifndef HID_AUX
#define HID_AUX 2
#endif
#ifndef STAG_IN
#define STAG_IN 16
#define STAG_FF1 16
#define STAG_Y 0
#endif
#ifndef RELAX_EPI
#define RELAX_EPI 1
#endif
#ifndef L1_I8
#define L1_I8 3
#endif
#ifndef L0_I8
#define L0_I8 2
#endif
#ifndef IN0_I8
#define IN0_I8 1
#endif
#ifndef FOX_WIN
#define FOX_WIN 1
#endif
#ifndef X16
#define X16 1
#endif
#ifndef IN1_I8
#define IN1_I8 1
#endif
#ifndef DSA_K8
#define DSA_K8 1
#endif
#ifndef WQ_SIGMA
#define WQ_SIGMA 1
#endif
#ifndef HID_U8
#define HID_U8 1
#endif
#ifndef FFN2_FP8
#define FFN2_FP8 0
#endif
__device__ __forceinline__ unsigned pk_i8x4(float a, float b, float c, float d, float qs) {
    const unsigned ua = __builtin_bit_cast(unsigned, __builtin_fmaf(a, qs, 12582912.f)), ub = __builtin_bit_cast(unsigned, __builtin_fmaf(b, qs, 12582912.f));
    const unsigned uc = __builtin_bit_cast(unsigned, __builtin_fmaf(c, qs, 12582912.f)), ud = __builtin_bit_cast(unsigned, __builtin_fmaf(d, qs, 12582912.f));
    return __builtin_amdgcn_perm(ub, ua, 0x0c0c0400u) | __builtin_amdgcn_perm(ud, uc, 0x04000c0cu);
}
__device__ __forceinline__ unsigned pk_i8x4s(float a, float b, float c, float d, float qs, float& sq) {
    const float fa = __builtin_amdgcn_fmed3f(a * qs, -127.f, 127.f) + 12582912.f, fb = __builtin_amdgcn_fmed3f(b * qs, -127.f, 127.f) + 12582912.f;
    const float fc = __builtin_amdgcn_fmed3f(c * qs, -127.f, 127.f) + 12582912.f, fd = __builtin_amdgcn_fmed3f(d * qs, -127.f, 127.f) + 12582912.f;
    const float ra = fa - 12582912.f, rb = fb - 12582912.f, rc = fc - 12582912.f, rd = fd - 12582912.f; sq += (ra * ra + rb * rb) + (rc * rc + rd * rd);
    return __builtin_amdgcn_perm(__builtin_bit_cast(unsigned, fb), __builtin_bit_cast(unsigned, fa), 0x0c0c0400u) | __builtin_amdgcn_perm(__builtin_bit_cast(unsigned, fd), __builtin_bit_cast(unsigned, fc), 0x04000c0cu);
}
#undef MK_PER_PHASE
#define MK_PER_PHASE 0
namespace pg8 {
#define PG8_LAS __attribute__((address_space(3)))
typedef unsigned short bf16_t;
typedef short bf16x8 __attribute__((ext_vector_type(8)));
typedef _Float16 h16x8 __attribute__((ext_vector_type(8)));
typedef float f32x4 __attribute__((ext_vector_type(4)));
typedef unsigned u32x4 __attribute__((ext_vector_type(4)));
typedef int i32x8 __attribute__((ext_vector_type(8)));
__device__ __forceinline__ i32x8 cat8(bf16x8 a, bf16x8 b) { const u32x4 x = __builtin_bit_cast(u32x4, a), y = __builtin_bit_cast(u32x4, b); return (i32x8){(int)x.x, (int)x.y, (int)x.z, (int)x.w, (int)y.x, (int)y.y, (int)y.z, (int)y.w}; }
constexpr int BM = 256, BK = 64, HALF = 128, HTB = HALF * BK * 2  , STAGE_BYTES = 8 * HTB, NXCD = 8, WGM = 8;

__host__ __device__ __forceinline__ int lds_byte(int r, int c) { const int st = (r >> 4) * 2 + (c >> 5), rr = r & 15, cc = c & 31, ob = rr * 64 + cc * 2; return st * 1024 + (ob ^ (((ob >> 9) & 1) << 5)); }
__host__ __device__ __forceinline__ void stage_rc(int b, int& R, int& C) { const int st = b / 1024, sb = b % 1024, swz = sb ^ (((sb >> 9) & 1) << 5); R = (st >> 1) * 16 + swz / 64; C = (st & 1) * 32 + (swz % 64) / 2; }
__host__ __device__ __forceinline__ int perm32(int rho) { const int n = rho >> 4, i = rho & 15; return 8 * (i >> 2) + 4 * n + (i & 3); }

struct Unit { int pm, pn; };
struct Gemm { const bf16_t* A; const bf16_t* Bt; int M, N, K; };

struct StaticOrder {
    int nM, nN, nwg, G, c;
    __host__ __device__ void init(int M, int N, int G_, int c_) { nM = M / BM; nN = N / BM; nwg = nM * nN; G = G_; c = c_; }
    __host__ __device__ bool next(int i, Unit& u) const { return at((long)i * G + c, u); }
    __host__ __device__ bool at(long L, Unit& u) const {
        if (L >= nwg) return false;
        int wgid = (int)L; { const int q = nwg / NXCD, r = nwg % NXCD, xcd = wgid % NXCD, off = wgid / NXCD; wgid = (xcd < r ? xcd * (q + 1) : r * (q + 1) + (xcd - r) * q) + off; }
        const int nig = WGM * nN, gid = wgid / nig, fm = gid * WGM, gsz = (nM - fm) < WGM ? (nM - fm) : WGM;
        u.pm = fm + ((wgid % nig) % gsz); u.pn = (wgid % nig) / gsz; return true;
    }
    __device__ __forceinline__ void a_ready(const Unit&) const {}
    __device__ __forceinline__ void done(const Unit&) const {}
};
struct DealOrder {
    StaticOrder S; int c, G;
    __host__ __device__ void init(int M, int N, int G_, int c_) { S.init(M, N, G_, c_); c = c_; G = G_; }
    __host__ __device__ bool next(int i, Unit& u) const {
        if (G != 256 || S.nwg != 1152) return S.next(i, u);
        if (i < 4) return S.at((long)i * 256 + c, u);
        if (i == 4 && c >= 128) return S.at(1024 + (c - 128), u);
        return false;
    }
    __device__ __forceinline__ void a_ready(const Unit&) const {}
    __device__ __forceinline__ void done(const Unit&) const {}
};

__device__ __forceinline__ unsigned cvt_pk_bf16(float lo, float hi) { unsigned r; asm volatile("v_cvt_pk_f16_f32 %0, %1, %2" : "=v"(r) : "v"(lo), "v"(hi)); return r; }
__device__ __forceinline__ void store_rowpair(bf16_t* O, int ldc, int row, int col0, bool odd, u32x4 w0, u32x4 w1) {
    const u32x4 give = odd ? w0 : w1; u32x4 got;
    got.x = (unsigned)__shfl_xor((int)give.x, 1); got.y = (unsigned)__shfl_xor((int)give.y, 1); got.z = (unsigned)__shfl_xor((int)give.z, 1); got.w = (unsigned)__shfl_xor((int)give.w, 1);
    const int re = row - (odd ? 1 : 0);
    bf16_t* p = O + (size_t)re * ldc + col0 + (odd ? 32 : 0);
    *(u32x4*)p = odd ? got : w0;
    *(u32x4*)(p + ldc) = odd ? w1 : got;
}
template <int ACT, bool BLK = false> struct EpiBf16 {
    static constexpr bool PERM = true, AFTER_DRAIN = false;
    bf16_t* O; int ldc; int c_lo, c_hi; float scale; const int* cs = nullptr; const float* rinv = nullptr; const float* winv = nullptr;
    __device__ __forceinline__ void operator()(const f32x4 (&acc)[2][2][4][2], const Unit& u, int wr, int wc, int fr_in, int fq_in) const {
        int fr = fr_in, fq = fq_in; asm volatile("" : "+v"(fr), "+v"(fq));
        const int row0 = u.pm * BM + wr * 64 + fr; const int col0 = u.pn * BM + wc * 64 + 8 * fq;
        typedef int i4c_ __attribute__((ext_vector_type(4)));
        i4c_ cadd[2][2] = {};
        if (ACT == 5) {
#pragma unroll
            for (int bj = 0; bj < 2; ++bj) { cadd[bj][0] = *(const i4c_*)(cs + col0 + bj * 32) * 128; cadd[bj][1] = *(const i4c_*)(cs + col0 + bj * 32 + 4) * 128; } }
        const __amdgpu_buffer_rsrc_t rsrc = __builtin_amdgcn_make_buffer_rsrc((void*)O, 0, 0x7fffffff, 0x00020000);
        const bool odd = fr & 1;
        float rs8[2][4];
        if (ACT == 6) { const float wi = winv[0];
#pragma unroll
            for (int ai = 0; ai < 2; ++ai)
#pragma unroll
                for (int m = 0; m < 4; ++m) rs8[ai][m] = rinv[row0 + ai * HALF + m * 16] * wi; }
#pragma unroll
        for (int ai = 0; ai < 2; ++ai)
#pragma unroll
            for (int m = 0; m < 4; ++m) { const int row = row0 + ai * HALF + m * 16; u32x4 w[2];
                float rsc = 1.f; if (ACT == 6) rsc = rs8[ai][m];
#pragma unroll
                for (int bj = 0; bj < 2; ++bj) { f32x4 v0 = acc[ai][bj][m][0], v1 = acc[ai][bj][m][1];
                    if (ACT == 6) { typedef int i4_ __attribute__((ext_vector_type(4)));
                        const int cb = col0 + bj * 32; const float sc = ((cb >= c_lo && cb < c_hi) ? scale : 1.f) * rsc;
                        v0 = __builtin_convertvector(__builtin_bit_cast(i4_, v0), f32x4) * sc; v1 = __builtin_convertvector(__builtin_bit_cast(i4_, v1), f32x4) * sc; }
                    else if (ACT == 2) { typedef int i4_ __attribute__((ext_vector_type(4)));
                        v0 = __builtin_convertvector(__builtin_bit_cast(i4_, v0), f32x4) * 0x1p-15f; v1 = __builtin_convertvector(__builtin_bit_cast(i4_, v1), f32x4) * 0x1p-15f;
                        v0 = __builtin_elementwise_max(v0, (f32x4){0.f, 0.f, 0.f, 0.f}); v1 = __builtin_elementwise_max(v1, (f32x4){0.f, 0.f, 0.f, 0.f}); v0 = v0 * v0; v1 = v1 * v1;
                        v0 = __builtin_elementwise_min(v0, (f32x4){60000.f, 60000.f, 60000.f, 60000.f}); v1 = __builtin_elementwise_min(v1, (f32x4){60000.f, 60000.f, 60000.f, 60000.f}); }
                    else if (ACT == 4 || ACT == 5) { typedef int i4_ __attribute__((ext_vector_type(4)));
                        i4_ a0 = __builtin_bit_cast(i4_, v0), a1 = __builtin_bit_cast(i4_, v1); if (ACT == 5) { a0 += cadd[bj][0]; a1 += cadd[bj][1]; }
                        v0 = __builtin_convertvector(a0, f32x4) * (ACT == 5 ? 0x1p-13f : 0x1p-12f); v1 = __builtin_convertvector(a1, f32x4) * (ACT == 5 ? 0x1p-13f : 0x1p-12f); }
                    else if (ACT == 1) { v0 = __builtin_elementwise_max(v0, (f32x4){0.f, 0.f, 0.f, 0.f}); v1 = __builtin_elementwise_max(v1, (f32x4){0.f, 0.f, 0.f, 0.f}); v0 = v0 * v0; v1 = v1 * v1; }
                    else { const int cb = col0 + bj * 32; const float sc = (cb >= c_lo && cb < c_hi) ? scale : 1.f; v0 = v0 * sc; v1 = v1 * sc; }
                    w[bj].x = cvt_pk_bf16(v0[0], v0[1]); w[bj].y = cvt_pk_bf16(v0[2], v0[3]); w[bj].z = cvt_pk_bf16(v1[0], v1[1]); w[bj].w = cvt_pk_bf16(v1[2], v1[3]); }
                if (BLK) {
#pragma unroll
                    for (int bj = 0; bj < 2; ++bj) { const unsigned r_ = (unsigned)row, c_ = (unsigned)(col0 + bj * 32);
                        __builtin_amdgcn_raw_buffer_store_b128(w[bj], rsrc, ((r_ >> 4) * (unsigned)(ldc >> 5) + (c_ >> 5)) * 1024u + (unsigned)(fr * 64 + fq * 16), 0, (ACT == 1 || ACT == 2) ? 2 : 0); } }
                else store_rowpair(O, ldc, row, col0, odd, w[0], w[1]); }
    }
};
struct EpiF8Hid {
    static constexpr bool PERM = true, AFTER_DRAIN = false;
    unsigned char* O; int kbytes;
    __device__ __forceinline__ void operator()(const f32x4 (&acc)[2][2][4][2], const Unit& u, int wr, int wc, int fr_in, int fq_in) const {
        int fr = fr_in, fq = fq_in; asm volatile("" : "+v"(fr), "+v"(fq));
        const int row0 = u.pm * BM + wr * 64 + fr; const unsigned blkcol = (unsigned)(u.pn * 4 + wc);
        const __amdgpu_buffer_rsrc_t rsrc = __builtin_amdgcn_make_buffer_rsrc((void*)O, 0, 0x7fffffff, 0x00020000);
        const bool odd = fq & 1;
#pragma unroll
        for (int ai = 0; ai < 2; ++ai)
#pragma unroll
            for (int m = 0; m < 4; ++m) { const unsigned row = (unsigned)(row0 + ai * HALF + m * 16); unsigned pc[2][2];
#pragma unroll
                for (int bj = 0; bj < 2; ++bj) { f32x4 v0 = acc[ai][bj][m][0], v1 = acc[ai][bj][m][1];
                    v0 = __builtin_elementwise_max(v0, (f32x4){0.f, 0.f, 0.f, 0.f}); v1 = __builtin_elementwise_max(v1, (f32x4){0.f, 0.f, 0.f, 0.f}); v0 = v0 * v0 * 2.f; v1 = v1 * v1 * 2.f;
                    unsigned d0 = 0u, d1 = 0u;
                    d0 = (unsigned)__builtin_amdgcn_cvt_pk_fp8_f32(v0[0], v0[1], (int)d0, false); d0 = (unsigned)__builtin_amdgcn_cvt_pk_fp8_f32(v0[2], v0[3], (int)d0, true);
                    d1 = (unsigned)__builtin_amdgcn_cvt_pk_fp8_f32(v1[0], v1[1], (int)d1, false); d1 = (unsigned)__builtin_amdgcn_cvt_pk_fp8_f32(v1[2], v1[3], (int)d1, true);
                    pc[bj][0] = d0; pc[bj][1] = d1; }
                unsigned a0 = pc[0][0], b0_ = pc[1][0], a1 = pc[0][1], b1_ = pc[1][1];
                asm volatile("s_nop 1\n\tv_permlane16_swap_b32 %0, %1\n\tv_permlane16_swap_b32 %2, %3\n\ts_nop 1" : "+v"(a0), "+v"(b0_), "+v"(a1), "+v"(b1_));
                u32x4 w; w.x = a0; w.y = a1; w.z = b0_; w.w = b1_;
                const unsigned unit = (odd ? 2u : 0u) + (unsigned)(fq >> 1);
                __builtin_amdgcn_raw_buffer_store_b128(w, rsrc, ((row >> 4) * (unsigned)(kbytes >> 6) + blkcol) * 1024u + (unsigned)fr * 64u + unit * 16u, 0, 2); }
    }
};
struct EpiI8Hid {
    static constexpr bool PERM = true, AFTER_DRAIN = false;
    unsigned char* O; int kbytes; const float* rs;
    __device__ __forceinline__ void operator()(const f32x4 (&acc)[2][2][4][2], const Unit& u, int wr, int wc, int fr_in, int fq_in) const {
        int fr = fr_in, fq = fq_in; asm volatile("" : "+v"(fr), "+v"(fq));
        typedef int i4_ __attribute__((ext_vector_type(4)));
        const int row0 = u.pm * BM + wr * 64 + fr; const unsigned blkcol = (unsigned)(u.pn * 4 + wc);
        const __amdgpu_buffer_rsrc_t rsrc = __builtin_amdgcn_make_buffer_rsrc((void*)O, 0, 0x7fffffff, 0x00020000);
        const bool odd = fq & 1;
        float rs8[2][4];
#pragma unroll
        for (int ai = 0; ai < 2; ++ai)
#pragma unroll
            for (int m = 0; m < 4; ++m) rs8[ai][m] = __builtin_amdgcn_sqrtf(rs[row0 + ai * HALF + m * 16]);
#pragma unroll
        for (int ai = 0; ai < 2; ++ai)
#pragma unroll
            for (int m = 0; m < 4; ++m) { const unsigned row = (unsigned)(row0 + ai * HALF + m * 16); const float s1 = rs8[ai][m]; unsigned pc[2][2];
#pragma unroll
                for (int bj = 0; bj < 2; ++bj) { f32x4 v0 = __builtin_convertvector(__builtin_bit_cast(i4_, acc[ai][bj][m][0]), f32x4) * s1, v1 = __builtin_convertvector(__builtin_bit_cast(i4_, acc[ai][bj][m][1]), f32x4) * s1;
                    const float qm1 = HID_U8 ? 15.968719f : 11.269427f;
#pragma unroll
                    for (int e_ = 0; e_ < 4; ++e_) { const float t0 = __builtin_amdgcn_fmed3f(v0[e_], 0.f, qm1), t1 = __builtin_amdgcn_fmed3f(v1[e_], 0.f, qm1); v0[e_] = t0; v1[e_] = t1; }
                    v0 = v0 * v0 + 12582912.f; v1 = v1 * v1 + 12582912.f;
                    const u32x4 b0 = __builtin_bit_cast(u32x4, v0), b1 = __builtin_bit_cast(u32x4, v1);
                    pc[bj][0] = __builtin_amdgcn_perm(b0.y, b0.x, 0x0c0c0400u) | __builtin_amdgcn_perm(b0.w, b0.z, 0x04000c0cu);
                    pc[bj][1] = __builtin_amdgcn_perm(b1.y, b1.x, 0x0c0c0400u) | __builtin_amdgcn_perm(b1.w, b1.z, 0x04000c0cu);
                    if (HID_U8) { pc[bj][0] ^= 0x80808080u; pc[bj][1] ^= 0x80808080u; } }
                unsigned a0 = pc[0][0], b0_ = pc[1][0], a1 = pc[0][1], b1_ = pc[1][1];
                asm volatile("s_nop 1\n\tv_permlane16_swap_b32 %0, %1\n\tv_permlane16_swap_b32 %2, %3\n\ts_nop 1" : "+v"(a0), "+v"(b0_), "+v"(a1), "+v"(b1_));
                u32x4 w; w.x = a0; w.y = a1; w.z = b0_; w.w = b1_;
                const unsigned unit = (odd ? 2u : 0u) + (unsigned)(fq >> 1);
                __builtin_amdgcn_raw_buffer_store_b128(w, rsrc, ((row >> 4) * (unsigned)(kbytes >> 6) + blkcol) * 1024u + (unsigned)fr * 64u + unit * 16u, 0, 2); }
    }
};
typedef unsigned u32x2_ __attribute__((ext_vector_type(2)));
template <bool I8R = false> struct EpiRopeT {
    static constexpr bool PERM = true, AFTER_DRAIN = false;
    bf16_t* O; int ldc; const int* pos; const float* tab; float qscale; int cbase = 0; const float* rinv = nullptr; const float* winv = nullptr; unsigned char* k8 = nullptr; unsigned char* v8 = nullptr;
    __device__ __forceinline__ void operator()(const f32x4 (&acc)[2][2][4][2], const Unit& u, int wr, int wc, int fr_in, int fq_in) const {
        int fr = fr_in, fq = fq_in; asm volatile("" : "+v"(fr), "+v"(fq));
        const int row0 = u.pm * BM + wr * 64 + fr; const int col0 = cbase + u.pn * BM + wc * 64 + 8 * fq;
        float ih[2][4], il[2][4]; int kind[2]; float sc[2];
#pragma unroll
        for (int bj = 0; bj < 2; ++bj) { const int cb = col0 + bj * 32; int k = 0, i0 = 0; sc[bj] = 1.f;
            if (cb < 2176) { k = 1; i0 = (cb & 127) >> 1; if (cb < 2048) sc[bj] = qscale; }
            else if (cb >= 2304 && cb < 3392) { k = 2; i0 = 64 + ((cb & 63) >> 1); }
            kind[bj] = k;
#pragma unroll
            for (int p = 0; p < 4; ++p) { ih[bj][p] = k ? tab[2 * (i0 + p)] : 0.f; il[bj][p] = k ? tab[2 * (i0 + p) + 1] : 0.f; } }
        float pf8[2][4];
#pragma unroll
        for (int ai = 0; ai < 2; ++ai)
#pragma unroll
            for (int m = 0; m < 4; ++m) pf8[ai][m] = (float)pos[row0 + ai * HALF + m * 16];
        float rq8[2][4];
        if (I8R) { const float wi = winv[0];
#pragma unroll
            for (int ai = 0; ai < 2; ++ai)
#pragma unroll
                for (int m = 0; m < 4; ++m) rq8[ai][m] = rinv[row0 + ai * HALF + m * 16] * wi; }
#pragma unroll
        for (int ai = 0; ai < 2; ++ai)
#pragma unroll
            for (int m = 0; m < 4; ++m) { const int row = row0 + ai * HALF + m * 16; const float pf = pf8[ai][m]; u32x4 wq[2];
#pragma unroll
                for (int bj = 0; bj < 2; ++bj) { f32x4 v0 = acc[ai][bj][m][0], v1 = acc[ai][bj][m][1];
                    if (I8R) { typedef int i4_ __attribute__((ext_vector_type(4)));
                        v0 = __builtin_convertvector(__builtin_bit_cast(i4_, v0), f32x4) * rq8[ai][m]; v1 = __builtin_convertvector(__builtin_bit_cast(i4_, v1), f32x4) * rq8[ai][m]; }
                    if (kind[bj]) { float x[8] = {v0[0], v0[1], v0[2], v0[3], v1[0], v1[1], v1[2], v1[3]};
#pragma unroll
                        for (int p = 0; p < 4; ++p) { const float rh = pf * ih[bj][p]; const float e = __builtin_fmaf(pf, ih[bj][p], -rh) + pf * il[bj][p];
                            const float frc = (rh - __builtin_floorf(rh)) + e; const float sn = __builtin_amdgcn_sinf(frc), cs = __builtin_amdgcn_cosf(frc);
                            const float a = x[2 * p], b = x[2 * p + 1]; x[2 * p] = (a * cs - b * sn) * sc[bj]; x[2 * p + 1] = (b * cs + a * sn) * sc[bj]; }
                        v0 = (f32x4){x[0], x[1], x[2], x[3]}; v1 = (f32x4){x[4], x[5], x[6], x[7]}; }
                    wq[bj].x = cvt_pk_bf16(v0[0], v0[1]); wq[bj].y = cvt_pk_bf16(v0[2], v0[3]); wq[bj].z = cvt_pk_bf16(v1[0], v1[1]); wq[bj].w = cvt_pk_bf16(v1[2], v1[3]);
                    if (I8R && DSA_K8) { const int cb = col0 + bj * 32; if (k8 != nullptr && cb >= 2048 && cb < 2176) { float sq_ = 0.f; u32x2_ w8;
                            w8.x = pk_i8x4s(v0[0], v0[1], v0[2], v0[3], 127.f / 6.f, sq_); w8.y = pk_i8x4s(v1[0], v1[1], v1[2], v1[3], 127.f / 6.f, sq_);
                            *(u32x2_*)(k8 + (size_t)row * 128 + (cb - 2048)) = w8; }
                        if (v8 != nullptr && cb >= 2176 && cb < 2304) { float sq_ = 0.f; u32x2_ w8;
                            w8.x = pk_i8x4s(v0[0], v0[1], v0[2], v0[3], 127.f / 6.f, sq_); w8.y = pk_i8x4s(v1[0], v1[1], v1[2], v1[3], 127.f / 6.f, sq_);
                            *(u32x2_*)(v8 + (size_t)row * 128 + (cb - 2176)) = w8; } } }
                store_rowpair(O, ldc, row, col0, (fr & 1) != 0, wq[0], wq[1]); }
    }
};
typedef EpiRopeT<false> EpiRope;
typedef int i32x4_ __attribute__((ext_vector_type(4)));
template <class Epi, class Sched, bool ALIGN_EPI = false, bool SP2 = false, bool A_BLK = false, bool F8 = false, bool I8 = false>
__device__ __forceinline__ void gemm_phase(PG8_LAS unsigned char* lds, const Gemm g, const Sched& S, const Epi& E) {
    int tid = threadIdx.x; asm volatile("" : "+v"(tid));
    const int wid = __builtin_amdgcn_readfirstlane(tid >> 6), lane = tid & 63, wr = wid >> 2, wc = wid & 3, fr = lane & 15, fq = lane >> 4;
    const int K = g.K, nt = K / BK;
    unsigned voffA[2], voffB[2];
#pragma unroll
    for (int i = 0; i < 2; ++i) { int R, C; stage_rc(tid * 16 + i * 8192, R, C); const int Rb = Epi::PERM ? (64 * (R >> 5) + perm32(R & 31)) : R;
        voffA[i] = A_BLK ? (unsigned)(((R >> 4) * (K >> 5) + (C >> 5)) * 1024 + (R & 15) * 64 + (C & 31) * 2) : (unsigned)(R * K + C) * 2u; voffB[i] = (unsigned)(Rb * K + C) * 2u; }
    const size_t kstep = (size_t)(BK * 2);
    const size_t kstepA = A_BLK ? (size_t)2048 : kstep;
    const size_t hstep = (size_t)HALF * K * 2;
    const size_t hstepB = (size_t)32 * K * 2;
    const size_t tstep = 2 * hstep;
    const unsigned ldsw = (unsigned)wid * 1024u;
    const int aoff = lds_byte(wr * 64 + fr, fq * 8), boff = lds_byte(wc * 32 + fr, fq * 8);
#define PG8_SA(b, h) (((b) * 2 + (h)) * HTB)
#define PG8_SB(b, h) ((4 + (b) * 2 + (h)) * HTB)
#define PG8_STAGE(bufoff, gbase, voff) do { _Pragma("unroll") for (int _i = 0; _i < 2; ++_i) \
        __builtin_amdgcn_global_load_lds((const unsigned*)((const char*)(gbase) + (voff)[_i]), (PG8_LAS unsigned*)(lds + (bufoff) + ldsw + _i * 8192), 16, 0, 0); } while (0)
#define PG8_LDA(dst, b, h) do { if constexpr (F8) { _Pragma("unroll") for (int m = 0; m < 4; ++m) dst##8[m] = cat8(*(const PG8_LAS bf16x8*)(lds + PG8_SA(b, h) + aoff + m * 2048), *(const PG8_LAS bf16x8*)(lds + PG8_SA(b, h) + aoff + m * 2048 + 1024)); } \
        else { _Pragma("unroll") for (int m = 0; m < 4; ++m) _Pragma("unroll") for (int k = 0; k < 2; ++k) dst[m][k] = *(const PG8_LAS bf16x8*)(lds + PG8_SA(b, h) + aoff + m * 2048 + k * 1024); } } while (0)
#define PG8_LDB(dst, b, h) do { if constexpr (F8) { _Pragma("unroll") for (int n = 0; n < 2; ++n) dst##8[n] = cat8(*(const PG8_LAS bf16x8*)(lds + PG8_SB(b, h) + boff + n * 2048), *(const PG8_LAS bf16x8*)(lds + PG8_SB(b, h) + boff + n * 2048 + 1024)); } \
        else { _Pragma("unroll") for (int n = 0; n < 2; ++n) _Pragma("unroll") for (int k = 0; k < 2; ++k) dst[n][k] = *(const PG8_LAS bf16x8*)(lds + PG8_SB(b, h) + boff + n * 2048 + k * 1024); } } while (0)
#define PG8_MMA(ai, bj, At, Bt) do { __builtin_amdgcn_s_setprio(1); \
        if constexpr (F8) { _Pragma("unroll") for (int m = 0; m < 4; ++m) _Pragma("unroll") for (int n = 0; n < 2; ++n) acc[ai][bj][m][n] = __builtin_amdgcn_mfma_scale_f32_16x16x128_f8f6f4(Bt##8[n], At##8[m], acc[ai][bj][m][n], 0, 0, 0, 0, 0, 0); } \
        else if constexpr (I8) { _Pragma("unroll") for (int m = 0; m < 4; ++m) _Pragma("unroll") for (int n = 0; n < 2; ++n) _Pragma("unroll") for (int k = 0; k < 2; ++k) \
        acc[ai][bj][m][n] = __builtin_bit_cast(f32x4, __builtin_amdgcn_mfma_i32_16x16x64_i8(__builtin_bit_cast(i32x4_, Bt[n][k]), __builtin_bit_cast(i32x4_, At[m][k]), __builtin_bit_cast(i32x4_, acc[ai][bj][m][n]), 0, 0, 0)); } \
        else { _Pragma("unroll") for (int m = 0; m < 4; ++m) _Pragma("unroll") for (int n = 0; n < 2; ++n) _Pragma("unroll") for (int k = 0; k < 2; ++k) \
        acc[ai][bj][m][n] = __builtin_amdgcn_mfma_f32_16x16x32_f16(__builtin_bit_cast(h16x8, Bt[n][k]), __builtin_bit_cast(h16x8, At[m][k]), acc[ai][bj][m][n], 0, 0, 0); } __builtin_amdgcn_s_setprio(0); } while (0)
#define PG8_WAIT_V(n) asm volatile("s_waitcnt vmcnt(" #n ")" ::: "memory")
#define PG8_WAIT_L(n) asm volatile("s_waitcnt lgkmcnt(" #n ")" ::: "memory")
#define PG8_BAR __builtin_amdgcn_s_barrier()
#define PG8_SCHED __builtin_amdgcn_sched_barrier(0)
    Unit cur, nxt; int ui = 0;
    if (!S.next(0, cur)) return;
    f32x4 acc[2][2][4][2];
#pragma unroll
    for (int a = 0; a < 2; ++a)
#pragma unroll
        for (int b = 0; b < 2; ++b)
#pragma unroll
            for (int m = 0; m < 4; ++m)
#pragma unroll
                for (int n = 0; n < 2; ++n) acc[a][b][m][n] = (f32x4){0.f, 0.f, 0.f, 0.f};
    bf16x8 At[4][2], B0[2][2], B1[2][2]; i32x8 At8[4], B08[2], B18[2];
    const char* cA = (const char*)g.A + (size_t)cur.pm * tstep; const char* cB = (const char*)g.Bt + (size_t)cur.pn * tstep;
    S.a_ready(cur);
    if constexpr (SP2) {
        PG8_STAGE(PG8_SB(0, 0), cB, voffB); PG8_STAGE(PG8_SB(0, 1), cB + hstepB, voffB); PG8_STAGE(PG8_SA(0, 0), cA, voffA); PG8_STAGE(PG8_SA(0, 1), cA + hstep, voffA);
        if (wr == 1) PG8_BAR;
        PG8_WAIT_V(2); PG8_BAR;
        PG8_STAGE(PG8_SB(1, 0), cB + kstep, voffB); PG8_STAGE(PG8_SA(1, 0), cA + kstepA, voffA); PG8_STAGE(PG8_SB(1, 1), cB + hstepB + kstep, voffB);
        PG8_WAIT_V(6); PG8_BAR;
    } else {
        PG8_STAGE(PG8_SB(0, 0), cB, voffB); PG8_STAGE(PG8_SA(0, 0), cA, voffA); PG8_STAGE(PG8_SB(0, 1), cB + hstepB, voffB); PG8_STAGE(PG8_SA(0, 1), cA + hstep, voffA);
        if (wr == 1) PG8_BAR;
        PG8_WAIT_V(4); PG8_BAR;
        PG8_STAGE(PG8_SB(1, 0), cB + kstep, voffB); PG8_STAGE(PG8_SA(1, 0), cA + kstepA, voffA); PG8_STAGE(PG8_SB(1, 1), cB + hstepB + kstep, voffB);
        PG8_WAIT_V(6); PG8_BAR;
    }
    for (;;) {
        const bool has_next = S.next(ui + 1, nxt);
        const char* nA = has_next ? (const char*)g.A + (size_t)nxt.pm * tstep : cA; const char* nB = has_next ? (const char*)g.Bt + (size_t)nxt.pn * tstep : cB;
        for (int t = 0; t < nt; t += 2) {
            const bool last = (t == nt - 2);
            const char* a1 = cA + (size_t)(t + 1) * kstepA;
            const char* a2 = last ? nA : cA + (size_t)(t + 2) * kstepA; const char* b2 = last ? nB : cB + (size_t)(t + 2) * kstep;
            const char* a3 = a2 + kstepA; const char* b3 = b2 + kstep;
            if (last && has_next) S.a_ready(nxt);
            if constexpr (SP2) {
            PG8_LDB(B0, 0, 0); PG8_LDB(B1, 0, 1); PG8_SCHED; PG8_LDA(At, 0, 0); PG8_STAGE(PG8_SA(1, 1), a1 + hstep, voffA);
            PG8_WAIT_V(8); PG8_WAIT_L(0); PG8_BAR; PG8_MMA(0, 0, At, B0); PG8_MMA(0, 1, At, B1); PG8_BAR; PG8_SCHED;
            PG8_LDA(At, 0, 1); PG8_STAGE(PG8_SB(0, 0), b2, voffB); PG8_STAGE(PG8_SB(0, 1), b2 + hstepB, voffB); PG8_STAGE(PG8_SA(0, 0), a2, voffA);
            PG8_WAIT_V(8); PG8_WAIT_L(0); PG8_BAR; PG8_MMA(1, 0, At, B0); PG8_MMA(1, 1, At, B1); PG8_BAR; PG8_SCHED;
            PG8_LDB(B0, 1, 0); PG8_LDB(B1, 1, 1); PG8_SCHED; PG8_LDA(At, 1, 0); PG8_STAGE(PG8_SA(0, 1), a2 + hstep, voffA);
            PG8_WAIT_V(8); PG8_WAIT_L(0); PG8_BAR; PG8_MMA(0, 0, At, B0); PG8_MMA(0, 1, At, B1); PG8_BAR; PG8_SCHED;
            PG8_LDA(At, 1, 1); PG8_STAGE(PG8_SB(1, 0), b3, voffB); PG8_STAGE(PG8_SB(1, 1), b3 + hstepB, voffB); PG8_STAGE(PG8_SA(1, 0), a3, voffA);
            PG8_WAIT_V(8); PG8_WAIT_L(0); PG8_BAR; PG8_MMA(1, 0, At, B0); PG8_MMA(1, 1, At, B1); PG8_BAR; PG8_SCHED;
            } else {
            PG8_LDB(B0, 0, 0); PG8_SCHED; PG8_LDA(At, 0, 0); PG8_STAGE(PG8_SA(1, 1), a1 + hstep, voffA);
            PG8_WAIT_L(8); PG8_BAR; PG8_WAIT_L(0); PG8_MMA(0, 0, At, B0); PG8_BAR; PG8_SCHED;
            PG8_LDB(B1, 0, 1); PG8_STAGE(PG8_SB(0, 0), b2, voffB);
            PG8_BAR; PG8_WAIT_L(0); PG8_MMA(0, 1, At, B1); PG8_BAR;
            PG8_LDA(At, 0, 1); PG8_STAGE(PG8_SA(0, 0), a2, voffA);
            PG8_BAR; PG8_WAIT_L(0); PG8_MMA(1, 0, At, B0); PG8_BAR; PG8_SCHED;
            PG8_STAGE(PG8_SB(0, 1), b2 + hstepB, voffB);
            PG8_WAIT_V(6); PG8_BAR; PG8_MMA(1, 1, At, B1); PG8_BAR;
            PG8_LDB(B0, 1, 0); PG8_SCHED; PG8_LDA(At, 1, 0); PG8_STAGE(PG8_SA(0, 1), a2 + hstep, voffA);
            PG8_WAIT_L(8); PG8_BAR; PG8_WAIT_L(0); PG8_MMA(0, 0, At, B0); PG8_BAR; PG8_SCHED;
            PG8_LDB(B1, 1, 1); PG8_STAGE(PG8_SB(1, 0), b3, voffB);
            PG8_BAR; PG8_WAIT_L(0); PG8_MMA(0, 1, At, B1); PG8_BAR;
            PG8_LDA(At, 1, 1); PG8_STAGE(PG8_SA(1, 0), a3, voffA);
            PG8_BAR; PG8_WAIT_L(0); PG8_MMA(1, 0, At, B0); PG8_BAR; PG8_SCHED;
            PG8_STAGE(PG8_SB(1, 1), b3 + hstepB, voffB);
            PG8_WAIT_V(6); PG8_BAR; PG8_MMA(1, 1, At, B1); PG8_BAR;
            }
        }
        if constexpr (ALIGN_EPI) { if (wr == 0) PG8_BAR; }
        if constexpr (!Epi::AFTER_DRAIN) { E(acc, cur, wr, wc, fr, fq); S.done(cur); }
        if (!has_next) break;
#pragma unroll
        for (int a = 0; a < 2; ++a)
#pragma unroll
            for (int b = 0; b < 2; ++b)
#pragma unroll
                for (int m = 0; m < 4; ++m)
#pragma unroll
                    for (int n = 0; n < 2; ++n) acc[a][b][m][n] = (f32x4){0.f, 0.f, 0.f, 0.f};
        cur = nxt; cA = nA; cB = nB; ++ui;
        if constexpr (ALIGN_EPI) { if (wr == 1) PG8_BAR; }
    }
    PG8_WAIT_V(0);
    if constexpr (!ALIGN_EPI) { if (wr == 0) PG8_BAR; }
    PG8_BAR;
    if constexpr (Epi::AFTER_DRAIN) { E.fused(acc, cur, wr, wc, fr, fq, lds, wid, lane); S.done(cur); }
#undef PG8_SA
#undef PG8_SB
#undef PG8_STAGE
#undef PG8_LDA
#undef PG8_LDB
#undef PG8_MMA
#undef PG8_WAIT_V
#undef PG8_WAIT_L
#undef PG8_BAR
#undef PG8_SCHED
}
}
namespace att {
typedef _Float16 h16x8 __attribute__((ext_vector_type(8)));
typedef short s16x8_ __attribute__((ext_vector_type(8))); typedef float f32x16_ __attribute__((ext_vector_type(16)));
__device__ __forceinline__ f32x16_ MFMA32_H(s16x8_ a, s16x8_ b, f32x16_ c, int, int, int) { return __builtin_amdgcn_mfma_f32_32x32x16_f16(__builtin_bit_cast(h16x8, a), __builtin_bit_cast(h16x8, b), c, 0, 0, 0); }
enum { ORDER_NATURAL = 0, ORDER_REVERSED = 1, ORDER_PAIRED = 2, ORDER_XCD = 4 };
using TIN = __hip_bfloat16; using TOUT = __hip_bfloat16;
constexpr int SQ = 4096, SKV = 4096, D = 128, QOFF = 0, WINDOW = SKV;
constexpr int LDQ = 6144, LDO = 2048;
#define BOFF(r, c) ((size_t)((((r) >> 4) * (LDQ / 32) + ((c) >> 5)) * 512 + ((r) & 15) * 32 + ((c) & 31)))
#define ST_ROW(tid) (16 * ((tid) >> 8) + (((tid) & 63) >> 2))
#define ST_COL(tid) ((4 * (((tid) >> 6) & 3) + ((tid) & 3)) * 8)
constexpr float THR = 8.f;
constexpr bool WSKIP = false;
constexpr float SCALE = 0.08838834764831845f;
constexpr int NW = 8, QBLK = 32, KVBLK = 64, QB = NW * QBLK;
constexpr int SHM_V = KVBLK * D * 2, SHM_K = KVBLK * D * 2;
constexpr int LDS_TILES = 2 * SHM_V + 2 * SHM_K + NW * 64 * 4;
constexpr int LDS_FB = LDS_TILES;
constexpr int LDS_BYTES = LDS_FB + SKV * 4 + 256;
constexpr int LDS_SB_BYTES = 2 * SHM_V + 2 * SHM_K + NW * QBLK * 256;
using bf16 = __hip_bfloat16;
typedef short bf16x8 __attribute__((ext_vector_type(8)));
typedef short s16x4 __attribute__((ext_vector_type(4)));
typedef float f32x16 __attribute__((ext_vector_type(16)));
typedef float f32x4 __attribute__((ext_vector_type(4)));
typedef unsigned u32x4 __attribute__((ext_vector_type(4)));
template <class A, class Bt> struct same_t { static constexpr bool v = false; };
template <class A> struct same_t<A, A> { static constexpr bool v = true; };

#define KSWZ(row, colB) ((row) * 256 + ((colB) ^ (((row) & 7) << 4)))
#define SBAR() __builtin_amdgcn_sched_barrier(0)
__device__ __forceinline__ int v_st(int k, int c) { const int kk = (k & ~0xC) | ((k & 4) << 1) | ((k & 8) >> 1); return ((kk >> 3) * 4 + (c >> 5)) * 512 + ((kk & 7) * 32 + (c & 31)) * 2; }
__device__ __forceinline__ int v_rd_base(int lane) { return ((lane & 3) << 3) | (((lane >> 2) & 3) << 6) | (((lane >> 4) & 1) << 5) | (((lane >> 5) & 1) << 8); }
constexpr int v_rd_off(int d0, int ks, int half) { return d0 * 512 + ks * 4096 + half * 2048; }
__device__ __forceinline__ int crow(int r, int hi) { return (r & 3) + 8 * (r >> 2) + 4 * hi; }
__device__ __forceinline__ unsigned cvtpk(float lo, float hi) {
    unsigned r; asm volatile("v_cvt_pk_f16_f32 %0, %1, %2" : "=v"(r) : "v"(lo), "v"(hi)); return r;
}
__device__ __forceinline__ bf16x8 pack8(f32x4 a, f32x4 b) {
    u32x4 w = {cvtpk(a[0], a[1]), cvtpk(a[2], a[3]), cvtpk(b[0], b[1]), cvtpk(b[2], b[3])};
    return *reinterpret_cast<bf16x8*>(&w);
}
template <class T> __device__ __forceinline__ bf16x8 load8(const T* p) {
    if constexpr (same_t<T, float>::v) { return pack8(*(const f32x4*)p, *(const f32x4*)(p + 4)); }
    else { return *reinterpret_cast<const bf16x8*>(p); }
}
__device__ __forceinline__ void mask_tile(f32x16& p0, f32x16& p1, int dq, unsigned W) {
    const float NEG = -__builtin_inff();
#pragma unroll
    for (int r = 0; r < 16; ++r) {
        const int c = (r & 3) + 8 * (r >> 2);
        if ((unsigned)(dq - c) >= W) p0[r] = NEG;
        if ((unsigned)(dq - c - 32) >= W) p1[r] = NEG;
    }
}
__device__ __forceinline__ void partialSM(f32x16& p0, f32x16& p1, float& m_reg, float& mn, float& alpha) {
    float pmax = p0[0]; for (int r = 1; r < 16; ++r) pmax = fmaxf(pmax, p0[r]); for (int r = 0; r < 16; ++r) pmax = fmaxf(pmax, p1[r]);
    { auto rr = __builtin_amdgcn_permlane32_swap(__float_as_uint(pmax), __float_as_uint(pmax), false, false);
      pmax = fmaxf(__uint_as_float(rr[0]), __uint_as_float(rr[1])); }
    constexpr float C2 = 1.4426950408889634f * SCALE;
    if (__builtin_expect(__all((pmax - m_reg) * SCALE <= THR), 1)) { mn = m_reg; alpha = 1.f; }
    else { mn = fmaxf(m_reg, pmax); alpha = __builtin_amdgcn_exp2f((m_reg - mn) * C2); m_reg = mn; }
    const float mnL = -mn * C2;
    for (int r = 0; r < 16; ++r) p0[r] = fmaf(p0[r], C2, mnL); for (int r = 0; r < 16; ++r) p1[r] = fmaf(p1[r], C2, mnL);
    for (int r = 0; r < 16; ++r) p0[r] = __builtin_amdgcn_exp2f(p0[r]);
}
__device__ __forceinline__ void finishSM(f32x16& p0, f32x16& p1, float alpha, float& l_reg, bf16x8& pa0, bf16x8& pa1, bf16x8& pa2, bf16x8& pa3) {
    for (int r = 0; r < 16; ++r) p1[r] = __builtin_amdgcn_exp2f(p1[r]);
    float ps = 0; for (int r = 0; r < 16; ++r) ps += p0[r]; for (int r = 0; r < 16; ++r) ps += p1[r];
    { auto rr = __builtin_amdgcn_permlane32_swap(__float_as_uint(ps), __float_as_uint(ps), false, false);
      ps = __uint_as_float(rr[0]) + __uint_as_float(rr[1]); }
    l_reg = l_reg * alpha + ps;
#define PK4(P, B_, OUT) do { unsigned a0 = cvtpk(P[B_+0], P[B_+1]), a1 = cvtpk(P[B_+2], P[B_+3]);                          \
        unsigned b0 = cvtpk(P[B_+4], P[B_+5]), b1 = cvtpk(P[B_+6], P[B_+7]);                                             \
        auto r0 = __builtin_amdgcn_permlane32_swap(a0, b0, false, false); auto r1 = __builtin_amdgcn_permlane32_swap(a1, b1, false, false); \
        u32x4 w = {r0[0], r1[0], r0[1], r1[1]}; OUT = *reinterpret_cast<bf16x8*>(&w); } while (0)
    PK4(p0, 0, pa0); PK4(p0, 8, pa1); PK4(p1, 0, pa2); PK4(p1, 8, pa3);
#undef PK4
}
template <int KB, bool SK, bool BIAS>
__device__ __forceinline__ void qkt(f32x16& p0, f32x16& p1, const char* K_lds, int r32, int hi, const bf16x8* qr, bool act, unsigned fbt) {
    if (SK && !act) { const float NEG = -__builtin_inff();
#pragma unroll
        for (int r = 0; r < 16; ++r) { p0[r] = NEG; p1[r] = NEG; } return; }
    if constexpr (BIAS) { typedef __attribute__((address_space(3))) const f32x4* lp4; const lp4 f4 = (lp4)fbt;
#pragma unroll
        for (int g = 0; g < 4; ++g) { const f32x4 a = f4[2 * g], b = f4[8 + 2 * g];
            p0[4 * g] = a[0]; p0[4 * g + 1] = a[1]; p0[4 * g + 2] = a[2]; p0[4 * g + 3] = a[3];
            p1[4 * g] = b[0]; p1[4 * g + 1] = b[1]; p1[4 * g + 2] = b[2]; p1[4 * g + 3] = b[3]; } }
    else { p0 = f32x16{}; p1 = f32x16{}; }
    const char* kb[4];
#pragma unroll
    for (int dd = 0; dd < 4; ++dd) kb[dd] = K_lds + KB * SHM_K + KSWZ(r32, (dd * 16 + hi * 8) * 2);
#pragma unroll
    for (int d0 = 0; d0 < 8; ++d0) { const char* a = kb[d0 & 3] + (d0 >> 2) * 128;
        bf16x8 b0 = *reinterpret_cast<const bf16x8*>(a);
        bf16x8 b1 = *reinterpret_cast<const bf16x8*>(a + 32 * 256);
        p0 = MFMA32_H(b0, qr[d0], p0, 0, 0, 0);
        p1 = MFMA32_H(b1, qr[d0], p1, 0, 0, 0); }
}
template <int VB, bool SK>
__device__ __forceinline__ void pv_tile(f32x16* o, int vb0, bf16x8 pa0, bf16x8 pa1, bf16x8 pa2, bf16x8 pa3, bool act) {
    if (SK && !act) return;
#define TRRD(dst, off) asm volatile("ds_read_b64_tr_b16 %0, %1 offset:%2" : "=&v"(dst) : "v"(vb0), "i"(off) : "memory")
#define PV_D0(d0) do { s16x4 l0, l1, l2, l3, h0, h1, h2, h3; constexpr int b_ = VB * SHM_V + v_rd_off(d0, 0, 0);     \
        TRRD(l0, b_); TRRD(h0, b_ + 2048); TRRD(l1, b_ + 4096); TRRD(h1, b_ + 6144); TRRD(l2, b_ + 8192); TRRD(h2, b_ + 10240); TRRD(l3, b_ + 12288); TRRD(h3, b_ + 14336); \
        asm volatile("s_waitcnt lgkmcnt(0)" ::: "memory"); SBAR();                 \
        o[d0] = MFMA32_H(pa0, (bf16x8){l0[0], l0[1], l0[2], l0[3], h0[0], h0[1], h0[2], h0[3]}, o[d0], 0, 0, 0);   \
        o[d0] = MFMA32_H(pa1, (bf16x8){l1[0], l1[1], l1[2], l1[3], h1[0], h1[1], h1[2], h1[3]}, o[d0], 0, 0, 0);   \
        o[d0] = MFMA32_H(pa2, (bf16x8){l2[0], l2[1], l2[2], l2[3], h2[0], h2[1], h2[2], h2[3]}, o[d0], 0, 0, 0);   \
        o[d0] = MFMA32_H(pa3, (bf16x8){l3[0], l3[1], l3[2], l3[3], h3[0], h3[1], h3[2], h3[3]}, o[d0], 0, 0, 0); } while (0)
    PV_D0(0); PV_D0(1); PV_D0(2); PV_D0(3);
#undef PV_D0
#undef TRRD
}

template <class TIn, class TOut> struct BlockRef { const TIn* Q; const TIn* K; const TIn* V; TOut* O; int P0; };
template <class TIn> struct Seam {
    bf16x8 qr[8];
    bf16x8 st_v0, st_v1, st_k0, st_k1; f32x4 sf0, sf1, sf2, sf3;
    f32x4 tq[16];
};
__device__ __forceinline__ int swa_jlo(int P0, int W) { const int lowk = P0 - W + 1; return lowk > 0 ? lowk / KVBLK : 0; }
#define ROW(p, k0, rr) ((p) + BOFF((k0) + (rr), sc))
#define VMW() asm volatile("s_waitcnt vmcnt(0)" ::: "memory")
#define VMWN(n) asm volatile("s_waitcnt vmcnt(%0)" :: "i"(n) : "memory")
#define SLOAD_H(Kp, Vp, k0) do { S.st_v0 = load8<TIn>(ROW(Vp, k0, sr)); S.st_v1 = load8<TIn>(ROW(Vp, k0, 32 + sr));              \
                         S.st_k0 = load8<TIn>(ROW(Kp, k0, sr)); S.st_k1 = load8<TIn>(ROW(Kp, k0, 32 + sr)); } while (0)
#define SWRITE_HK(bf) do { *(bf16x8*)(K_lds + (bf) * SHM_K + kws) = S.st_k0; *(bf16x8*)(K_lds + (bf) * SHM_K + kws + 32 * 256) = S.st_k1; } while (0)
#define SWRITE_HV(bf) do { *(bf16x8*)(V_lds + (bf) * SHM_V + vst0) = S.st_v0; *(bf16x8*)(V_lds + (bf) * SHM_V + vst1) = S.st_v1; } while (0)
#define SWRITE_H(bf) do { SWRITE_HV(bf); SWRITE_HK(bf); } while (0)
#define SLOAD_F(p, k0) do { S.sf0 = *(const f32x4*)ROW(p, k0, sr); S.sf1 = *(const f32x4*)(ROW(p, k0, sr) + 4);                \
                            S.sf2 = *(const f32x4*)ROW(p, k0, 32 + sr); S.sf3 = *(const f32x4*)(ROW(p, k0, 32 + sr) + 4); } while (0)
#define SWRITE_KF(bf) do { *(bf16x8*)(K_lds + (bf) * SHM_K + kws) = pack8(S.sf0, S.sf1); *(bf16x8*)(K_lds + (bf) * SHM_K + kws + 32 * 256) = pack8(S.sf2, S.sf3); } while (0)
#define SWRITE_VF(bf) do { *(bf16x8*)(V_lds + (bf) * SHM_V + vst0) = pack8(S.sf0, S.sf1); *(bf16x8*)(V_lds + (bf) * SHM_V + vst1) = pack8(S.sf2, S.sf3); } while (0)
template <class TIn, class TOut>
__device__ __forceinline__ void causal_swa_prime(const BlockRef<TIn, TOut>& cur, int W, char* lds, Seam<TIn>& S) {
    constexpr bool F32 = same_t<TIn, float>::v;
    int tid = threadIdx.x; asm volatile("" : "+v"(tid)); const int wid = __builtin_amdgcn_readfirstlane(tid >> 6), lane = tid & 63, r32 = lane & 31, hi = lane >> 5;
    const int sr = ST_ROW(tid), sc = ST_COL(tid), kws = KSWZ(sr, sc * 2); char* K_lds = lds + 2 * SHM_V;
    const int kb0 = swa_jlo(cur.P0, W) * KVBLK;
    for (int d0 = 0; d0 < 8; ++d0) S.qr[d0] = load8<TIn>(cur.Q + BOFF(wid * QBLK + r32, d0 * 16 + hi * 8));
    if constexpr (F32) { SLOAD_F((const float*)cur.K, kb0); VMW(); SWRITE_KF(0); SBAR(); SLOAD_F((const float*)cur.V, kb0); }
    else { SLOAD_H(cur.K, cur.V, kb0); VMW(); SWRITE_HK(0); }
    __syncthreads();
}
template <class TIn, class TOut, bool FB = true>
__device__ __forceinline__ void causal_swa_block(const BlockRef<TIn, TOut>& cur, const BlockRef<TIn, TOut>& nxt, int skv, int W, char* lds, Seam<TIn>& S, unsigned fb) {
    constexpr bool F32 = same_t<TIn, float>::v;
    int tid = threadIdx.x; asm volatile("" : "+v"(tid)); const int wid = __builtin_amdgcn_readfirstlane(tid >> 6), lane = tid & 63, r32 = lane & 31, hi = lane >> 5;
    const int j_lo = swa_jlo(cur.P0, W);
    int j_hi = (cur.P0 + QB - 1) / KVBLK + 1; if (j_hi > skv / KVBLK) j_hi = skv / KVBLK;
    const int NT = j_hi - j_lo;
    const int kbn = swa_jlo(nxt.P0, W) * KVBLK;
    const int qlo = cur.P0 + wid * QBLK, qm = qlo + r32 - 4 * hi;
    char* V_lds = lds; char* K_lds = lds + 2 * SHM_V;
    float* ws = (float*)(lds + 2 * SHM_V + 2 * SHM_K) + wid * 64; float* li_l = ws, * al_l = ws + 32;
    float m_reg = -1e30f, l_reg = 0; f32x16 o[4] = {};
    const int sr = ST_ROW(tid), sc = ST_COL(tid), vst0 = v_st(sr, sc), vst1 = v_st(32 + sr, sc), kws = KSWZ(sr, sc * 2);
    const int vb0 = (int)(uintptr_t)V_lds + v_rd_base(lane);
    const TIn* Kh = cur.K; const TIn* Vh = cur.V;
#define RESC(a) do { if (__any((a) < 1.f)) { if (hi == 0) al_l[r32] = (a); asm volatile("s_waitcnt lgkmcnt(0)" ::: "memory");              \
                     for (int d_ = 0; d_ < 4; ++d_) for (int r = 0; r < 16; ++r) o[d_][r] *= al_l[crow(r, hi)]; } } while (0)
#define KBASE(t) ((j_lo + (t)) * KVBLK)
#define ACT(t) (KBASE(t) <= qlo + QBLK - 1 && KBASE(t) + KVBLK - 1 >= qlo - W + 1)
#define MASKT(P0_, P1_, t) do { const int kb_ = KBASE(t); if ((!SK || ACT(t)) && (kb_ + KVBLK - 1 > qlo || kb_ <= qlo + QBLK - 1 - W)) mask_tile(P0_, P1_, qm - kb_, (unsigned)W); } while (0)
    constexpr int NQL = F32 ? 16 : 8;
    constexpr bool SK = WSKIP && !F32;
#define SEAM_K0() do { VMWN(NQL); if constexpr (F32) { SWRITE_KF(0); SBAR(); SLOAD_F((const float*)nxt.V, kbn); } else { SWRITE_HK(0); } SBAR(); } while (0)
    f32x16 pA0, pA1, pB0, pB1; float mnA, mnB, alA, alB; bf16x8 pa0, pa1, pa2, pa3;
    if constexpr (F32) { VMW(); SWRITE_VF(0); SBAR(); } else { SWRITE_HV(0); SBAR(); }
    if (NT > 1) { if constexpr (F32) SLOAD_F((const float*)Kh, KBASE(1)); else SLOAD_H(Kh, Vh, KBASE(1)); }
    SBAR(); qkt<0, SK, FB>(pA0, pA1, K_lds, r32, hi, S.qr, ACT(0), fb + (unsigned)(KBASE(0) + 4 * hi) * 4u);
    if constexpr (F32) { if (NT > 1) { VMW(); SWRITE_KF(1); SBAR(); SLOAD_F((const float*)Vh, KBASE(1)); } }
    MASKT(pA0, pA1, 0); partialSM(pA0, pA1, m_reg, mnA, alA);
    if (NT > 1) { VMW(); if constexpr (F32) { SWRITE_VF(1); SBAR(); if (NT > 2) SLOAD_F((const float*)Kh, KBASE(2)); } else SWRITE_H(1); }
    __syncthreads();
#define HALF_STEP(PX0, PX1, mnX, alX, PY0, PY1, alY, t, KB, VB, SB) do {                                                      \
        SBAR(); qkt<KB, SK, FB>(PX0, PX1, K_lds, r32, hi, S.qr, ACT(t), fb + (unsigned)(KBASE(t) + 4 * hi) * 4u);                                             \
        finishSM(PY0, PY1, alY, l_reg, pa0, pa1, pa2, pa3); SBAR();                                                           \
        if ((t) + 1 < NT) { if constexpr (F32) { VMW(); SWRITE_KF(SB); SBAR(); SLOAD_F((const float*)Vh, KBASE((t) + 1)); }  \
                            else { SLOAD_H(Kh, Vh, KBASE((t) + 1)); } SBAR(); }                                               \
        pv_tile<VB, SK>(o, vb0, pa0, pa1, pa2, pa3, ACT((t) - 1)); MASKT(PX0, PX1, (t)); partialSM(PX0, PX1, m_reg, mnX, alX);                                        \
        __syncthreads();                                                                                                      \
        if ((t) + 1 < NT) { VMW(); if constexpr (F32) { SWRITE_VF(SB); SBAR(); if ((t) + 2 < NT) SLOAD_F((const float*)Kh, KBASE((t) + 2)); } \
                            else { SWRITE_H(SB); } }                                                                          \
        RESC(alX); __syncthreads(); } while (0)
    for (int t = 1; t + 1 < NT; t += 2) {
        HALF_STEP(pB0, pB1, mnB, alB, pA0, pA1, alA, t, 1, 0, 0);
        HALF_STEP(pA0, pA1, mnA, alA, pB0, pB1, alB, t + 1, 0, 1, 1);
    }
    const bool even = (NT & 1) == 0;
    if (even) { SBAR(); qkt<1, SK, FB>(pB0, pB1, K_lds, r32, hi, S.qr, ACT(NT - 1), fb + (unsigned)(KBASE(NT - 1) + 4 * hi) * 4u); SBAR(); }
#define QROW(e) (nxt.Q + (size_t)(wid * QBLK + r32) * LDQ + ((e) >> 1) * 16 + hi * 8 + ((e) & 1) * 4)
    if constexpr (F32) { SLOAD_F((const float*)nxt.K, kbn); SBAR();
#pragma unroll
        for (int e = 0; e < 8; ++e) S.tq[e] = *(const f32x4*)QROW(e); }
    else { SLOAD_H(nxt.K, nxt.V, kbn); SBAR();
#pragma unroll
        for (int d0 = 0; d0 < 8; ++d0) S.qr[d0] = load8<TIn>(nxt.Q + BOFF(wid * QBLK + r32, d0 * 16 + hi * 8)); }
    SBAR();
    finishSM(pA0, pA1, alA, l_reg, pa0, pa1, pa2, pa3); SBAR();
    if constexpr (F32) {
#pragma unroll
        for (int e = 8; e < 16; ++e) S.tq[e] = *(const f32x4*)QROW(e); SBAR(); }
#undef QROW
    pv_tile<0, SK>(o, vb0, pa0, pa1, pa2, pa3, ACT(even ? NT - 2 : NT - 1));
    if (even) { MASKT(pB0, pB1, NT - 1); partialSM(pB0, pB1, m_reg, mnB, alB); __syncthreads(); RESC(alB);
        finishSM(pB0, pB1, alB, l_reg, pa0, pa1, pa2, pa3); SBAR(); pv_tile<1, SK>(o, vb0, pa0, pa1, pa2, pa3, ACT(NT - 1)); }
    SBAR(); SEAM_K0();
    if (hi == 0) li_l[r32] = l_reg; asm volatile("s_waitcnt lgkmcnt(0)" ::: "memory");
    float rli[16];
#pragma unroll
    for (int r = 0; r < 16; ++r) rli[r] = __builtin_amdgcn_rcpf(li_l[crow(r, hi)]);
    TOut* Ow = cur.O + (size_t)(wid * QBLK) * LDO;
#pragma unroll
    for (int r = 0; r < 16; ++r) { const int orow = crow(r, hi);
#pragma unroll
        for (int d0 = 0; d0 < 4; ++d0) { const float v = o[d0][r] * rli[r];
            if constexpr (same_t<TOut, float>::v) { Ow[(size_t)orow * LDO + d0 * 32 + r32] = v; }
            else { const float vn = __shfl_xor(v, 1);
                   if ((r32 & 1) == 0) *(unsigned*)(Ow + (size_t)orow * LDO + d0 * 32 + r32) = cvtpk(v, vn); } } }
    if constexpr (F32) {
#pragma unroll
        for (int d0 = 0; d0 < 8; ++d0) S.qr[d0] = pack8(S.tq[2 * d0], S.tq[2 * d0 + 1]); }
    __syncthreads();
#undef RESC
#undef KBASE
#undef ACT
#undef MASKT
#undef SEAM_K0
#undef HALF_STEP
}
#undef ROW
#undef VMW
#undef VMWN
#undef SLOAD_H
#undef SWRITE_HK
#undef SWRITE_HV
#undef SWRITE_H
#undef SLOAD_F
#undef SWRITE_KF
#undef SWRITE_VF
typedef _Float16 f16x8 __attribute__((ext_vector_type(8)));
__device__ __forceinline__ f16x8 pack_f16(const f32x16& v, int b) {
    u32x4 w;
    w.x = __builtin_bit_cast(unsigned, __builtin_amdgcn_cvt_pkrtz(v[b + 0], v[b + 1])); w.y = __builtin_bit_cast(unsigned, __builtin_amdgcn_cvt_pkrtz(v[b + 2], v[b + 3]));
    w.z = __builtin_bit_cast(unsigned, __builtin_amdgcn_cvt_pkrtz(v[b + 4], v[b + 5])); w.w = __builtin_bit_cast(unsigned, __builtin_amdgcn_cvt_pkrtz(v[b + 6], v[b + 7]));
    return __builtin_bit_cast(f16x8, w);
}
template <int KB, int H>
__device__ __forceinline__ void qk_half(f32x16& p, const char* K_lds, const char* Q_lds, int r32, int hi) {
    p = f32x16{};
    int ko[4];
#pragma unroll
    for (int dd = 0; dd < 4; ++dd) ko[dd] = KSWZ(r32, (dd * 16 + hi * 8) * 2);
#pragma unroll
    for (int d0 = 0; d0 < 8; ++d0) { const bf16x8 b = *reinterpret_cast<const bf16x8*>(K_lds + KB * SHM_K + H * 32 * 256 + ko[d0 & 3] + (d0 >> 2) * 128);
        const bf16x8 q = *reinterpret_cast<const bf16x8*>(Q_lds + ko[d0 & 3] + (d0 >> 2) * 128);
        p = MFMA32_H(b, q, p, 0, 0, 0);
        if (d0 & 1) SBAR(); }
}
#define SB_PK4(P, B_, OUT) do { unsigned a0 = cvtpk(P[B_+0], P[B_+1]), a1 = cvtpk(P[B_+2], P[B_+3]);                          \
        unsigned b0 = cvtpk(P[B_+4], P[B_+5]), b1 = cvtpk(P[B_+6], P[B_+7]);                                             \
        auto r0 = __builtin_amdgcn_permlane32_swap(a0, b0, false, false); auto r1 = __builtin_amdgcn_permlane32_swap(a1, b1, false, false); \
        u32x4 w = {r0[0], r1[0], r0[1], r1[1]}; OUT = *reinterpret_cast<bf16x8*>(&w); } while (0)
template <int KB, int H>
__device__ __forceinline__ void sb_half(f32x16& Racc, const char* K_lds, const char* Q_lds, int r32, int hi, int dq, bool need_mask, f16x8 tri0, f16x8 tri1, f16x8 ones, bf16x8& paA, bf16x8& paB) {
    f32x16 p, s;
    qk_half<KB, H>(p, K_lds, Q_lds, r32, hi);
#pragma unroll
    for (int r = 0; r < 16; ++r) { const float z = p[r]; const float e = __builtin_amdgcn_exp2f(-__builtin_fabsf(z)); const float sp = fmaxf(z, 0.f) + __builtin_amdgcn_logf(1.f + e); s[r] = sp; p[r] = z - sp; }
    if (need_mask) { const float NEG = -__builtin_inff();
#pragma unroll
        for (int r = 0; r < 16; ++r) { const int c = (r & 3) + 8 * (r >> 2) + 32 * H; if (!(c < dq)) { s[r] = 0.f; p[r] = NEG; } } }
    const f16x8 La = pack_f16(s, 0), Lb = pack_f16(s, 8);
    f32x16 C = __builtin_amdgcn_mfma_f32_32x32x16_f16(tri0, La, Racc, 0, 0, 0); C = __builtin_amdgcn_mfma_f32_32x32x16_f16(tri1, Lb, C, 0, 0, 0);
    Racc = __builtin_amdgcn_mfma_f32_32x32x16_f16(ones, La, Racc, 0, 0, 0); Racc = __builtin_amdgcn_mfma_f32_32x32x16_f16(ones, Lb, Racc, 0, 0, 0);
#pragma unroll
    for (int r = 0; r < 16; ++r) p[r] = __builtin_amdgcn_exp2f(p[r] - C[r]);
    SB_PK4(p, 0, paA); SB_PK4(p, 8, paB);
}
template <int KB>
__device__ __forceinline__ void sb_tile(f32x16* o, f32x16& Racc, const char* K_lds, const char* Q_lds, int vb0, int r32, int hi, int dq, bool need_mask, f16x8 tri0, f16x8 tri1, f16x8 ones) {
    bf16x8 pa0, pa1, pa2, pa3;
    sb_half<KB, 1>(Racc, K_lds, Q_lds, r32, hi, dq, need_mask, tri0, tri1, ones, pa2, pa3);
    SBAR();
    sb_half<KB, 0>(Racc, K_lds, Q_lds, r32, hi, dq, need_mask, tri0, tri1, ones, pa0, pa1);
    pv_tile<KB, false>(o, vb0, pa0, pa1, pa2, pa3, true);
}
__device__ __forceinline__ void sb_block(const bf16* Q, const bf16* K, const bf16* V, bf16* O, int P0, char* lds, volatile int* dead_flags  ) {
    int tid = threadIdx.x; asm volatile("" : "+v"(tid)); const int wid = __builtin_amdgcn_readfirstlane(tid >> 6), lane = tid & 63, r32 = lane & 31, hi = lane >> 5;
    const int NT = P0 / KVBLK + QB / KVBLK;
    const int qlo = P0 + wid * QBLK, qpos = qlo + r32;
    char* V_lds = lds; char* K_lds = lds + 2 * SHM_V;
    const int sr = ST_ROW(tid), sc = ST_COL(tid), vst0 = v_st(sr, sc), vst1 = v_st(32 + sr, sc), kws = KSWZ(sr, sc * 2);
    const int vb0 = (int)(uintptr_t)V_lds + v_rd_base(lane);
    char* Q_lds = lds + 2 * SHM_V + 2 * SHM_K + wid * (QBLK * 256);
#pragma unroll
    for (int d0 = 0; d0 < 8; ++d0) *(bf16x8*)(Q_lds + KSWZ(r32, (d0 * 16 + hi * 8) * 2)) = load8<bf16>(Q + BOFF(wid * QBLK + r32, d0 * 16 + hi * 8));
    f16x8 tri0, tri1, ones;
#pragma unroll
    for (int j = 0; j < 8; ++j) { const int ka = 8 * (j >> 2) + 4 * hi + (j & 3); tri0[j] = (ka > r32) ? (_Float16)1.f : (_Float16)0.f; tri1[j] = (16 + ka > r32) ? (_Float16)1.f : (_Float16)0.f; ones[j] = (_Float16)1.f; }
    float zero = 0.f; asm volatile("" : "+v"(zero));
    f32x16 Racc, o[4];
#pragma unroll
    for (int r = 0; r < 16; ++r) { Racc[r] = zero; o[0][r] = zero; o[1][r] = zero; o[2][r] = zero; o[3][r] = zero; }
    bf16x8 st_k0, st_k1, st_v0, st_v1;
    const unsigned rowoff = (unsigned)BOFF(sr, sc);
#define SB_LOAD(k0) do { const bf16* kt_ = K + BOFF((k0), 0); const bf16* vt_ = V + BOFF((k0), 0); \
                         st_v0 = load8<bf16>(vt_ + rowoff); st_v1 = load8<bf16>(vt_ + BOFF(32, 0) + rowoff); \
                         st_k0 = load8<bf16>(kt_ + rowoff); st_k1 = load8<bf16>(kt_ + BOFF(32, 0) + rowoff); } while (0)
#define SB_WRITE(bf) do { *(bf16x8*)(K_lds + (bf) * SHM_K + kws) = st_k0; *(bf16x8*)(K_lds + (bf) * SHM_K + kws + 32 * 256) = st_k1; \
                          *(bf16x8*)(V_lds + (bf) * SHM_V + vst0) = st_v0; *(bf16x8*)(V_lds + (bf) * SHM_V + vst1) = st_v1; } while (0)
    SB_LOAD((NT - 1) * KVBLK); asm volatile("s_waitcnt vmcnt(0)" ::: "memory"); SB_WRITE((NT - 1) & 1);
    if (tid < NW) dead_flags[tid] = -1;
    __syncthreads();
    bool dead = false;
    for (int t = NT - 1; t >= 0; --t) {
        const int kb = t * KVBLK;
        if (t > 0) SB_LOAD(kb - KVBLK);
        if (!dead && kb < qlo + QBLK - 1) {
            const bool need_mask = kb + KVBLK - 1 >= qlo; const int dq = qpos - kb - 4 * hi;
            if (t & 1) sb_tile<1>(o, Racc, K_lds, Q_lds, vb0, r32, hi, dq, need_mask, tri0, tri1, ones);
            else       sb_tile<0>(o, Racc, K_lds, Q_lds, vb0, r32, hi, dq, need_mask, tri0, tri1, ones);
            dead = __all(Racc[0] >= 160.f);
            if (dead && lane == 0) dead_flags[wid] = t;
        }
        if (t > 0) { asm volatile("s_waitcnt vmcnt(0)" ::: "memory"); SB_WRITE((t - 1) & 1); }
        __syncthreads();
        int nd = 0;
#pragma unroll
        for (int w = 0; w < NW; ++w) nd += (dead_flags[w] >= t) ? 1 : 0;
        if (nd == NW) break;
    }
#undef SB_LOAD
#undef SB_WRITE
    int tid2 = threadIdx.x; asm volatile("" : "+v"(tid2));
    const int r32e = tid2 & 31, hie = (tid2 >> 5) & 1;
    bf16* Ow = O + (size_t)(wid * QBLK) * LDO;
#pragma unroll
    for (int r = 0; r < 16; ++r) { const int orow = crow(r, hie);
#pragma unroll
        for (int d0 = 0; d0 < 4; ++d0) { const float v = o[d0][r]; const float vn = __shfl_xor(v, 1);
            if ((r32e & 1) == 0) *(unsigned*)(Ow + (size_t)orow * LDO + d0 * 32 + r32e) = cvtpk(v, vn); } }
}
}
namespace dsa {
#define DLAS __attribute__((address_space(3)))
typedef short bf16x8 __attribute__((ext_vector_type(8)));
typedef short s16x4 __attribute__((ext_vector_type(4)));
typedef float f32x4 __attribute__((ext_vector_type(4)));
typedef float f32x16 __attribute__((ext_vector_type(16)));
typedef unsigned u32x4 __attribute__((ext_vector_type(4)));
typedef unsigned u32x2 __attribute__((ext_vector_type(2)));
typedef unsigned short bf16_t;
constexpr int LDP = 3584, LDO = 2048, S = 4096;
constexpr int C_K = 2048, C_V = 2176, C_QI = 2304, C_KI = 3328, C_WI = 3392;
constexpr int NWAVE_ = 8, KI_ROW = 144, KI_TILE = 128 * KI_ROW, KI_LDS = 2 * KI_TILE;
constexpr int VROW = 288, WAVE_LDS = 32 * VROW + 512;
__device__ __forceinline__ unsigned cvtpk(float lo, float hi) { unsigned r; asm volatile("v_cvt_pk_f16_f32 %0, %1, %2" : "=v"(r) : "v"(lo), "v"(hi)); return r; }
typedef _Float16 h16x8 __attribute__((ext_vector_type(8)));
__device__ __forceinline__ float bf2f(unsigned short v) { return (float)__builtin_bit_cast(_Float16, v); }

__device__ __forceinline__ void indexer2(const bf16_t* P, int tq0, int n_adm, float* Iscr, int lane_) {
    int lane = lane_; asm volatile("" : "+v"(lane));
    const int r32 = lane & 31, hi = lane >> 5;
    bf16x8 aq[2][4]; float wA[2][8], wB[2][8];
#pragma unroll
    for (int p = 0; p < 2; ++p) {
        const bf16_t* src = P + (unsigned)((tq0 + 2 * p + (r32 >> 4)) * LDP + C_QI + (r32 & 15) * 64 + hi * 8);
#pragma unroll
        for (int s = 0; s < 4; ++s) aq[p][s] = *(const bf16x8*)(src + 16 * s);
        const bf16_t* wa = P + (unsigned)((tq0 + 2 * p) * LDP + C_WI + 4 * hi); const bf16_t* wb = wa + LDP;
        const u32x2 a0 = *(const u32x2*)wa, a1 = *(const u32x2*)(wa + 8), b0 = *(const u32x2*)wb, b1 = *(const u32x2*)(wb + 8);
        const float sc = 1.0f / 32.0f;
        wA[p][0] = bf2f(a0.x & 0xffff) * sc; wA[p][1] = bf2f(a0.x >> 16) * sc; wA[p][2] = bf2f(a0.y & 0xffff) * sc; wA[p][3] = bf2f(a0.y >> 16) * sc;
        wA[p][4] = bf2f(a1.x & 0xffff) * sc; wA[p][5] = bf2f(a1.x >> 16) * sc; wA[p][6] = bf2f(a1.y & 0xffff) * sc; wA[p][7] = bf2f(a1.y >> 16) * sc;
        wB[p][0] = bf2f(b0.x & 0xffff) * sc; wB[p][1] = bf2f(b0.x >> 16) * sc; wB[p][2] = bf2f(b0.y & 0xffff) * sc; wB[p][3] = bf2f(b0.y >> 16) * sc;
        wB[p][4] = bf2f(b1.x & 0xffff) * sc; wB[p][5] = bf2f(b1.x >> 16) * sc; wB[p][6] = bf2f(b1.y & 0xffff) * sc; wB[p][7] = bf2f(b1.y >> 16) * sc;
    }
    const unsigned koff = (unsigned)(r32 * LDP + C_KI + 8 * hi);
    const int nt = n_adm >> 5;
    bf16x8 bk[4], bn[4];
#pragma unroll
    for (int s = 0; s < 4; ++s) bk[s] = *(const bf16x8*)(P + koff + 16 * s);
    for (int j = 0; j < nt; ++j) {
        const bf16_t* kn = P + (size_t)((j + 1 < nt) ? (j + 1) * 32 : j * 32) * LDP;
#pragma unroll
        for (int s = 0; s < 4; ++s) bn[s] = *(const bf16x8*)(kn + koff + 16 * s);
#pragma unroll
        for (int p = 0; p < 2; ++p) {
            f32x16 acc = {};
#pragma unroll
            for (int s = 0; s < 4; ++s) acc = __builtin_amdgcn_mfma_f32_32x32x16_f16(__builtin_bit_cast(h16x8, aq[p][s]), __builtin_bit_cast(h16x8, bk[s]), acc, 0, 0, 0);
            float ia = 0.f, ib = 0.f;
#pragma unroll
            for (int r = 0; r < 8; ++r) { ia = __builtin_fmaf(fmaxf(acc[r], 0.f), wA[p][r], ia); ib = __builtin_fmaf(fmaxf(acc[8 + r], 0.f), wB[p][r], ib); }
            asm volatile("s_nop 1\n\tv_permlane32_swap_b32 %0, %1" : "+v"(ia), "+v"(ib));
            const float v = ia + ib;
            Iscr[(unsigned)((2 * p + hi) * S + 32 * j + r32)] = v;
        }
#pragma unroll
        for (int s = 0; s < 4; ++s) bk[s] = bn[s];
    }
    const int npad = (n_adm + 511) & ~511;
    for (int i = n_adm + lane; i < npad; i += 64) {
#pragma unroll
        for (int q = 0; q < 4; ++q) Iscr[(unsigned)(q * S + i)] = -__builtin_inff(); }
}

template <int MODE>
__device__ __forceinline__ void indexer_wg(const bf16_t* P, int tq0, int n_adm, float* Iscr, DLAS char* kbuf, int tid_) {
    int tid = tid_; asm volatile("" : "+v"(tid));
    const int lane = tid & 63, r32 = lane & 31, hi = lane >> 5;
    bf16x8 aq[2][4]; float wA[2][8], wB[2][8];
#pragma unroll
    for (int p = 0; p < 2; ++p) {
        const bf16_t* src = P + (unsigned)((tq0 + 2 * p + (r32 >> 4)) * LDP + C_QI + (r32 & 15) * 64 + hi * 8);
#pragma unroll
        for (int s = 0; s < 4; ++s) aq[p][s] = *(const bf16x8*)(src + 16 * s);
        const bf16_t* wa = P + (unsigned)((tq0 + 2 * p) * LDP + C_WI + 4 * hi); const bf16_t* wb = wa + LDP;
        const u32x2 a0 = *(const u32x2*)wa, a1 = *(const u32x2*)(wa + 8), b0 = *(const u32x2*)wb, b1 = *(const u32x2*)(wb + 8);
        const float sc = 1.0f / 32.0f;
        wA[p][0] = bf2f(a0.x & 0xffff) * sc; wA[p][1] = bf2f(a0.x >> 16) * sc; wA[p][2] = bf2f(a0.y & 0xffff) * sc; wA[p][3] = bf2f(a0.y >> 16) * sc;
        wA[p][4] = bf2f(a1.x & 0xffff) * sc; wA[p][5] = bf2f(a1.x >> 16) * sc; wA[p][6] = bf2f(a1.y & 0xffff) * sc; wA[p][7] = bf2f(a1.y >> 16) * sc;
        wB[p][0] = bf2f(b0.x & 0xffff) * sc; wB[p][1] = bf2f(b0.x >> 16) * sc; wB[p][2] = bf2f(b0.y & 0xffff) * sc; wB[p][3] = bf2f(b0.y >> 16) * sc;
        wB[p][4] = bf2f(b1.x & 0xffff) * sc; wB[p][5] = bf2f(b1.x >> 16) * sc; wB[p][6] = bf2f(b1.y & 0xffff) * sc; wB[p][7] = bf2f(b1.y >> 16) * sc;
    }
    const int srow = tid >> 3, sch = tid & 7;
    const unsigned sgo = (unsigned)(srow * LDP + C_KI + sch * 8);
    const unsigned slo = (unsigned)(srow * KI_ROW + (sch << 4));
    unsigned rdo[4];
#pragma unroll
    for (int s = 0; s < 4; ++s) rdo[s] = (unsigned)(r32 * KI_ROW + ((2 * s + hi) << 4));
    const int nt = (n_adm + 127) >> 7;
    const unsigned kb0 = (unsigned)(uintptr_t)kbuf;
    bf16x8 st0 = *(const bf16x8*)(P + sgo), st1 = *(const bf16x8*)(P + sgo + 64 * LDP);
    *(DLAS bf16x8*)(kb0 + slo) = st0; *(DLAS bf16x8*)(kb0 + slo + 64 * KI_ROW) = st1;
    __syncthreads();
    float pend[2][4]; int pend_kt = -1, pend_n = 0;
    for (int kt = 0; kt < nt; ++kt) {
        const unsigned cur = kb0 + (unsigned)((kt & 1) * KI_TILE), nxt = kb0 + (unsigned)(((kt + 1) & 1) * KI_TILE);
        if (pend_kt >= 0) {
#pragma unroll
            for (int sub = 0; sub < 4; ++sub) if (sub < pend_n) {
#pragma unroll
                for (int p = 0; p < 2; ++p) Iscr[(unsigned)((2 * p + hi) * S + pend_kt * 128 + sub * 32 + r32)] = pend[p][sub]; } }
        if (MODE != 2 && kt + 1 < nt) { const bf16_t* tp = P + (size_t)(kt + 1) * 128 * LDP; st0 = *(const bf16x8*)(tp + sgo); st1 = *(const bf16x8*)(tp + sgo + 64 * LDP); }
        const int nsub = (n_adm - kt * 128) >= 128 ? 4 : 2;
#pragma unroll
        for (int sp = 0; sp < 2; ++sp) if (MODE != 3 && 2 * sp < nsub) {
            bf16x8 bk[2][4];
#pragma unroll
            for (int u = 0; u < 2; ++u)
#pragma unroll
                for (int s = 0; s < 4; ++s) bk[u][s] = *(DLAS const bf16x8*)(cur + (unsigned)((2 * sp + u) * 32 * KI_ROW) + rdo[s]);
            f32x16 acc[2][2];
#pragma unroll
            for (int u = 0; u < 2; ++u)
#pragma unroll
                for (int p = 0; p < 2; ++p) acc[u][p] = (f32x16){};
#pragma unroll
            for (int s = 0; s < 4; ++s)
#pragma unroll
                for (int u = 0; u < 2; ++u)
#pragma unroll
                    for (int p = 0; p < 2; ++p) acc[u][p] = __builtin_amdgcn_mfma_f32_32x32x16_f16(__builtin_bit_cast(h16x8, aq[p][s]), __builtin_bit_cast(h16x8, bk[u][s]), acc[u][p], 0, 0, 0);
#pragma unroll
            for (int u = 0; u < 2; ++u)
#pragma unroll
                for (int p = 0; p < 2; ++p) {
                    float ia = 0.f, ib = 0.f;
                    if (MODE == 4) { asm volatile("" :: "v"(acc[u][p])); pend[p][2 * sp + u] = 0.f; continue; }
                    if (MODE == 1) { ia = acc[u][p][0]; ib = acc[u][p][8]; } else
#pragma unroll
                    for (int r = 0; r < 8; ++r) { ia = __builtin_fmaf(fmaxf(acc[u][p][r], 0.f), wA[p][r], ia); ib = __builtin_fmaf(fmaxf(acc[u][p][8 + r], 0.f), wB[p][r], ib); }
                    asm volatile("s_nop 1\n\tv_permlane32_swap_b32 %0, %1" : "+v"(ia), "+v"(ib));
                    pend[p][2 * sp + u] = ia + ib;
                }
        }
        pend_kt = kt; pend_n = nsub;
        if (MODE != 2) { if (kt + 1 < nt) { *(DLAS bf16x8*)(nxt + slo) = st0; *(DLAS bf16x8*)(nxt + slo + 64 * KI_ROW) = st1; }
        __syncthreads(); }
    }
#pragma unroll
    for (int sub = 0; sub < 4; ++sub) if (sub < pend_n) {
#pragma unroll
        for (int p = 0; p < 2; ++p) Iscr[(unsigned)((2 * p + hi) * S + pend_kt * 128 + sub * 32 + r32)] = pend[p][sub]; }
    const int npad = (n_adm + 511) & ~511;
    for (int i = n_adm + lane; i < npad; i += 64) {
#pragma unroll
        for (int q = 0; q < 4; ++q) Iscr[(unsigned)(q * S + i)] = -__builtin_inff(); }
}

__device__ __forceinline__ unsigned ordkey(float v) { const unsigned u = __builtin_bit_cast(unsigned, v); return (u & 0x80000000u) ? ~u : (u | 0x80000000u); }
__device__ __forceinline__ void topk256(const float* Irow, int n_adm, DLAS unsigned short* list, DLAS char* cbuf, int lane_) {
    int lane = lane_; asm volatile("" : "+v"(lane));
    const int nreg = n_adm >> 6;
    DLAS float* cv = (DLAS float*)cbuf; DLAS unsigned short* ci = (DLAS unsigned short*)(cbuf + 4096);
    unsigned key[16];
    const bool direct = nreg <= 16;
    if (direct) {
#pragma unroll
        for (int g8 = 0; g8 < 2; ++g8) {
            if (8 * g8 < nreg) {
#pragma unroll
                for (int jj = 0; jj < 8; ++jj) key[8 * g8 + jj] = ordkey(Irow[64 * (8 * g8 + jj) + lane]); }
            else {
#pragma unroll
                for (int jj = 0; jj < 8; ++jj) key[8 * g8 + jj] = 0u; } }
    } else {
        float v[64];
#pragma unroll
        for (int g8 = 0; g8 < 8; ++g8) {
            if (8 * g8 < nreg) {
#pragma unroll
                for (int jj = 0; jj < 8; ++jj) v[8 * g8 + jj] = Irow[64 * (8 * g8 + jj) + lane]; }
            else {
#pragma unroll
                for (int jj = 0; jj < 8; ++jj) v[8 * g8 + jj] = -__builtin_inff(); } }
        float s1 = 0.f, s2 = 0.f;
#pragma unroll
        for (int j = 0; j < 16; ++j) { s1 += v[j]; s2 = __builtin_fmaf(v[j], v[j], s2); }
#pragma unroll
        for (int o = 1; o < 64; o <<= 1) { s1 += __shfl_xor(s1, o); s2 += __shfl_xor(s2, o); }
        const float mu = s1 * (1.f / 1024.f), sd = sqrtf(fmaxf(s2 * (1.f / 1024.f) - mu * mu, 1e-20f));
        const float pq = 512.f / (float)n_adm, tq = sqrtf(-2.f * __logf(pq));
        const float zq = tq - (2.515517f + tq * (0.802853f + tq * 0.010328f)) / (1.f + tq * (1.432788f + tq * (0.189269f + tq * 0.001308f)));
        float L = mu + zq * sd; int c = 0;
        for (int tries = 0; tries < 64; ++tries) {
            int base = 0;
#pragma unroll
            for (int g8 = 0; g8 < 8; ++g8) if (8 * g8 < nreg) {
#pragma unroll
                for (int jj = 0; jj < 8; ++jj) { const int j = 8 * g8 + jj; const bool sel = v[j] > L; const unsigned long long m = __ballot(sel);
                    const int pos = base + (int)__builtin_amdgcn_mbcnt_hi((unsigned)(m >> 32), __builtin_amdgcn_mbcnt_lo((unsigned)m, 0u));
                    if (sel && pos < 1024) { cv[pos] = v[j]; ci[pos] = (unsigned short)(64 * j + lane); } base += __builtin_popcountll(m);
                    if ((jj & 3) == 3) __builtin_amdgcn_sched_barrier(0); } }
            c = base;
            if (c < 256) { L -= 0.35f * sd; continue; }
            if (c > 1024) { L += 0.35f * sd; continue; }
            break;
        }
        asm volatile("s_waitcnt lgkmcnt(0)" ::: "memory");
#pragma unroll
        for (int j = 0; j < 16; ++j) { const int i = 64 * j + lane; key[j] = (i < c) ? ordkey(cv[i]) : 0u; }
    }
    unsigned lo = 0u, hi = 0xFFFFFFFFu, thr; int cnt_hi = 0, need = 0;
    for (;;) {
        const unsigned mid = lo + ((hi - lo) >> 1);
        if (mid == lo) { thr = hi; need = 256 - cnt_hi; break; }
        int c = 0;
#pragma unroll
        for (int j = 0; j < 16; ++j) { c += __builtin_popcountll(__ballot(key[j] > mid)); if ((j & 3) == 3) __builtin_amdgcn_sched_barrier(0); }
        if (c == 256) { thr = mid; need = 0; break; }
        if (c > 256) lo = mid; else { hi = mid; cnt_hi = c; }
    }
    int base = 0;
#pragma unroll
    for (int j = 0; j < 16; ++j) { const bool sel = key[j] > thr; const unsigned long long m = __ballot(sel);
        const int pos = base + (int)__builtin_amdgcn_mbcnt_hi((unsigned)(m >> 32), __builtin_amdgcn_mbcnt_lo((unsigned)m, 0u));
        const unsigned short idx = direct ? (unsigned short)(64 * j + lane) : ci[64 * j + lane];
        if (sel && pos < 256) list[pos] = idx; base += __builtin_popcountll(m); }
    if (need > 0) {
#pragma unroll
        for (int j = 0; j < 16; ++j) { const bool sel = key[j] == thr; const unsigned long long m = __ballot(sel);
            const int pos = base + (int)__builtin_amdgcn_mbcnt_hi((unsigned)(m >> 32), __builtin_amdgcn_mbcnt_lo((unsigned)m, 0u));
            const unsigned short idx = direct ? (unsigned short)(64 * j + lane) : ci[64 * j + lane];
            if (sel && pos < 256) list[pos] = idx; base += __builtin_popcountll(m); }
    }
}

__device__ __forceinline__ bf16x8 dsa_i8x8_to_f16(u32x2 w) {
    typedef _Float16 h2 __attribute__((ext_vector_type(2)));
    const unsigned a = w.x ^ 0x80808080u, b = w.y ^ 0x80808080u; const unsigned hi = 0x64646464u;
    const unsigned p0 = __builtin_amdgcn_perm(hi, a, 0x04010400u), p1 = __builtin_amdgcn_perm(hi, a, 0x04030402u), p2 = __builtin_amdgcn_perm(hi, b, 0x04010400u), p3 = __builtin_amdgcn_perm(hi, b, 0x04030402u);
    const h2 off = {(_Float16)1152.f, (_Float16)1152.f};
    u32x4 r; r.x = __builtin_bit_cast(unsigned, (h2)(__builtin_bit_cast(h2, p0) - off)); r.y = __builtin_bit_cast(unsigned, (h2)(__builtin_bit_cast(h2, p1) - off));
    r.z = __builtin_bit_cast(unsigned, (h2)(__builtin_bit_cast(h2, p2) - off)); r.w = __builtin_bit_cast(unsigned, (h2)(__builtin_bit_cast(h2, p3) - off));
    return __builtin_bit_cast(bf16x8, r);
}
#define DSA_TRRD(dst, addr, off) asm volatile("ds_read_b64_tr_b16 %0, %1 offset:%2" : "=&v"(dst) : "v"(addr), "i"(off) : "memory")
__device__ __forceinline__ void sparse_attn(const bf16_t* P, int t, DLAS const unsigned short* list, int nv, DLAS char* vbuf, bf16_t* Orow, int lane_, const unsigned char* K8 = nullptr, const unsigned char* V8 = nullptr) {
    int lane = lane_; asm volatile("" : "+v"(lane));
    const int c16 = lane & 15, g = lane >> 4;
#if DSA_K8
    typedef int i32x4k __attribute__((ext_vector_type(4)));
    i32x4k q8[2]; float sqk;
    { const bf16_t* qp8 = P + (unsigned)(t * LDP + c16 * 128 + 16 * g); bf16x8 qf[2][2];
#pragma unroll
      for (int s = 0; s < 2; ++s) { qf[s][0] = *(const bf16x8*)(qp8 + 64 * s); qf[s][1] = *(const bf16x8*)(qp8 + 64 * s + 8); }
      float qv[32]; float mx = 0.f;
#pragma unroll
      for (int s = 0; s < 2; ++s)
#pragma unroll
          for (int hh = 0; hh < 2; ++hh)
#pragma unroll
              for (int j = 0; j < 8; ++j) { const float v = bf2f((unsigned short)qf[s][hh][j]); qv[16 * s + 8 * hh + j] = v; mx = fmaxf(mx, fabsf(v)); }
      mx = fmaxf(mx, __shfl_xor(mx, 16)); mx = fmaxf(mx, __shfl_xor(mx, 32)); mx = fmaxf(mx, 1e-30f);
      const float qs = 127.f / mx; sqk = mx * (1.f / 127.f) * (6.f / 127.f);
#pragma unroll
      for (int s = 0; s < 2; ++s) { q8[s][0] = (int)pk_i8x4(qv[16 * s + 0], qv[16 * s + 1], qv[16 * s + 2], qv[16 * s + 3], qs); q8[s][1] = (int)pk_i8x4(qv[16 * s + 4], qv[16 * s + 5], qv[16 * s + 6], qv[16 * s + 7], qs);
          q8[s][2] = (int)pk_i8x4(qv[16 * s + 8], qv[16 * s + 9], qv[16 * s + 10], qv[16 * s + 11], qs); q8[s][3] = (int)pk_i8x4(qv[16 * s + 12], qv[16 * s + 13], qv[16 * s + 14], qv[16 * s + 15], qs); } }
#else
    const bf16_t* qp = P + (unsigned)(t * LDP + c16 * 128 + 8 * g);
    bf16x8 bq[4];
#pragma unroll
    for (int s = 0; s < 4; ++s) bq[s] = *(const bf16x8*)(qp + 32 * s);
#endif
    const int nks = nv >> 5;
    const float NEG = -__builtin_inff();
#if DSA_K8
    i32x4k kx[2][2], ky[2][2], kz[2][2];
#define DSA_KLOAD(buf, pi) do { _Pragma("unroll") for (int k2 = 0; k2 < 2; ++k2) { const int key = list[16 * (2 * (pi) + k2) + c16]; const unsigned char* kp = K8 + (unsigned)(key * 128 + 16 * g); \
        _Pragma("unroll") for (int s = 0; s < 2; ++s) buf[k2][s] = *(const i32x4k*)(kp + 64 * s); } } while (0)
#define DSA_KCOMP(buf, pi) do { _Pragma("unroll") for (int k2 = 0; k2 < 2; ++k2) { i32x4k acci = {0, 0, 0, 0}; \
        _Pragma("unroll") for (int s = 0; s < 2; ++s) acci = __builtin_amdgcn_mfma_i32_16x16x64_i8(buf[k2][s], q8[s], acci, 0, 0, 0); \
        st[2 * (pi) + k2] = __builtin_convertvector(acci, f32x4) * sqk; } } while (0)
#else
    bf16x8 kx[2][4], ky[2][4], kz[2][4];
#define DSA_KLOAD(buf, pi) do { _Pragma("unroll") for (int k2 = 0; k2 < 2; ++k2) { const int key = list[16 * (2 * (pi) + k2) + c16]; const bf16_t* kp = P + (unsigned)(key * LDP + C_K + 8 * g); \
        _Pragma("unroll") for (int s = 0; s < 4; ++s) buf[k2][s] = *(const bf16x8*)(kp + 32 * s); } } while (0)
#define DSA_KCOMP(buf, pi) do { _Pragma("unroll") for (int k2 = 0; k2 < 2; ++k2) { f32x4 acc = {0.f, 0.f, 0.f, 0.f}; \
        _Pragma("unroll") for (int s = 0; s < 4; ++s) acc = __builtin_amdgcn_mfma_f32_16x16x32_f16(__builtin_bit_cast(h16x8, buf[k2][s]), __builtin_bit_cast(h16x8, bq[s]), acc, 0, 0, 0); \
        st[2 * (pi) + k2] = acc; } } while (0)
#endif
#define DSA_KNEG(pi) do { st[2 * (pi)] = (f32x4){NEG, NEG, NEG, NEG}; st[2 * (pi) + 1] = (f32x4){NEG, NEG, NEG, NEG}; } while (0)
    f32x4 st[16];
    const int npair = nks;
    DSA_KLOAD(kx, 0); DSA_KLOAD(ky, 1); if (npair > 2) DSA_KLOAD(kz, 2);
    DSA_KCOMP(kx, 0); if (npair > 3) DSA_KLOAD(kx, 3);
    DSA_KCOMP(ky, 1); if (npair > 4) DSA_KLOAD(ky, 4);
    if (npair > 2) { DSA_KCOMP(kz, 2); if (npair > 5) DSA_KLOAD(kz, 5); DSA_KCOMP(kx, 3); if (npair > 6) DSA_KLOAD(kx, 6); } else { DSA_KNEG(2); DSA_KNEG(3); }
    if (npair > 4) { DSA_KCOMP(ky, 4); if (npair > 7) DSA_KLOAD(ky, 7); DSA_KCOMP(kz, 5); } else { DSA_KNEG(4); DSA_KNEG(5); }
    if (npair > 6) { DSA_KCOMP(kx, 6); DSA_KCOMP(ky, 7); } else { DSA_KNEG(6); DSA_KNEG(7); }
#undef DSA_KLOAD
#undef DSA_KCOMP
#undef DSA_KNEG
#if DSA_K8
    u32x4 va_[4], vb_[4];
    const int vk8 = lane >> 3, vp8 = lane & 7;
#define DSA_VGATHER(buf, ks) do { _Pragma("unroll") for (int e = 0; e < 4; ++e) { const int key = list[32 * (ks) + vk8 + 8 * e]; buf[e] = *(const u32x4*)(V8 + (unsigned)(key * 128 + vp8 * 16)); } } while (0)
#else
    bf16x8 va_[8], vb_[8];
#define DSA_VGATHER(buf, ks) do { _Pragma("unroll") for (int e = 0; e < 8; ++e) { const int key = list[32 * (ks) + g + 4 * e]; buf[e] = *(const bf16x8*)(P + (unsigned)(key * LDP + C_V + c16 * 8)); } } while (0)
#endif
    DSA_VGATHER(va_, 0); DSA_VGATHER(vb_, 1);
    float m = NEG;
#pragma unroll
    for (int kt = 0; kt < 16; ++kt) m = fmaxf(fmaxf(fmaxf(m, st[kt][0]), fmaxf(st[kt][1], st[kt][2])), st[kt][3]);
    m = fmaxf(m, __shfl_xor(m, 16)); m = fmaxf(m, __shfl_xor(m, 32));
    float l = 0.f;
#pragma unroll
    for (int kt = 0; kt < 16; ++kt) {
#pragma unroll
        for (int i = 0; i < 4; ++i) { const float p = __builtin_amdgcn_exp2f(st[kt][i] - m); st[kt][i] = p; l += p; } }
    l += __shfl_xor(l, 16); l += __shfl_xor(l, 32);
    f32x4 oacc[8];
#pragma unroll
    for (int rb = 0; rb < 8; ++rb) oacc[rb] = (f32x4){0.f, 0.f, 0.f, 0.f};
    const unsigned vwr = (unsigned)(uintptr_t)vbuf + (unsigned)(g * VROW + c16 * 16);
    const unsigned vrd = (unsigned)(uintptr_t)vbuf + (unsigned)((4 * g + (c16 >> 2)) * VROW + (c16 & 3) * 8);
#if DSA_K8
    const unsigned vwr8 = (unsigned)(uintptr_t)vbuf + (unsigned)(vk8 * VROW + vp8 * 32);
#define DSA_VWRITE(buf) do { _Pragma("unroll") for (int e = 0; e < 4; ++e) { u32x2 lo_, hi_; lo_.x = buf[e].x; lo_.y = buf[e].y; hi_.x = buf[e].z; hi_.y = buf[e].w; \
        *(DLAS bf16x8*)(vwr8 + (unsigned)(8 * e * VROW)) = dsa_i8x8_to_f16(lo_); *(DLAS bf16x8*)(vwr8 + (unsigned)(8 * e * VROW) + 16u) = dsa_i8x8_to_f16(hi_); } } while (0)
#else
#define DSA_VWRITE(buf) do { _Pragma("unroll") for (int e = 0; e < 8; ++e) *(DLAS bf16x8*)(vwr + (unsigned)(4 * e * VROW)) = buf[e]; } while (0)
#endif
#define DSA_VSTEP(buf, ks) do { \
        DSA_VWRITE(buf); \
        if ((ks) + 2 < nks) DSA_VGATHER(buf, (ks) + 2); \
        u32x4 w; w.x = cvtpk(st[2 * (ks)][0], st[2 * (ks)][1]); w.y = cvtpk(st[2 * (ks)][2], st[2 * (ks)][3]); w.z = cvtpk(st[2 * (ks) + 1][0], st[2 * (ks) + 1][1]); w.w = cvtpk(st[2 * (ks) + 1][2], st[2 * (ks) + 1][3]); \
        const bf16x8 pb = __builtin_bit_cast(bf16x8, w); \
        s16x4 ta[8], tb[8]; \
        DSA_TRRD(ta[0], vrd, 0); DSA_TRRD(tb[0], vrd, 16 * VROW); DSA_TRRD(ta[1], vrd, 32); DSA_TRRD(tb[1], vrd, 16 * VROW + 32); DSA_TRRD(ta[2], vrd, 64); DSA_TRRD(tb[2], vrd, 16 * VROW + 64); DSA_TRRD(ta[3], vrd, 96); DSA_TRRD(tb[3], vrd, 16 * VROW + 96); \
        DSA_TRRD(ta[4], vrd, 128); DSA_TRRD(tb[4], vrd, 16 * VROW + 128); DSA_TRRD(ta[5], vrd, 160); DSA_TRRD(tb[5], vrd, 16 * VROW + 160); DSA_TRRD(ta[6], vrd, 192); DSA_TRRD(tb[6], vrd, 16 * VROW + 192); DSA_TRRD(ta[7], vrd, 224); DSA_TRRD(tb[7], vrd, 16 * VROW + 224); \
        asm volatile("s_waitcnt lgkmcnt(0)" ::: "memory"); __builtin_amdgcn_sched_barrier(0); \
        _Pragma("unroll") for (int rb = 0; rb < 8; ++rb) { const bf16x8 af = (bf16x8){ta[rb][0], ta[rb][1], ta[rb][2], ta[rb][3], tb[rb][0], tb[rb][1], tb[rb][2], tb[rb][3]}; \
            oacc[rb] = __builtin_amdgcn_mfma_f32_16x16x32_f16(__builtin_bit_cast(h16x8, af), __builtin_bit_cast(h16x8, pb), oacc[rb], 0, 0, 0); } } while (0)
    DSA_VSTEP(va_, 0); DSA_VSTEP(vb_, 1);
    if (nks > 2) { DSA_VSTEP(va_, 2); DSA_VSTEP(vb_, 3); }
    if (nks > 4) { DSA_VSTEP(va_, 4); DSA_VSTEP(vb_, 5); }
    if (nks > 6) { DSA_VSTEP(va_, 6); DSA_VSTEP(vb_, 7); }
#undef DSA_VSTEP
#undef DSA_VGATHER
#undef DSA_VWRITE
    const float rl = (DSA_K8 ? 6.f / 127.f : 1.0f) / l;
    if (L1_I8 >= 3) {
        float mx = 0.f;
#pragma unroll
        for (int rb = 0; rb < 8; ++rb) { oacc[rb] = oacc[rb] * rl; mx = fmaxf(fmaxf(mx, fmaxf(fabsf(oacc[rb][0]), fabsf(oacc[rb][1]))), fmaxf(fabsf(oacc[rb][2]), fabsf(oacc[rb][3]))); }
#pragma unroll
        for (int o_ = 1; o_ < 64; o_ <<= 1) mx = fmaxf(mx, __shfl_xor(mx, o_));
        const float qs = 127.f / fmaxf(mx, 1e-30f);
#pragma unroll
        for (int rb = 0; rb < 8; ++rb) *(unsigned*)((unsigned char*)Orow + c16 * 128 + 16 * rb + 4 * g) = pk_i8x4(oacc[rb][0], oacc[rb][1], oacc[rb][2], oacc[rb][3], qs);
    } else {
#pragma unroll
    for (int rb = 0; rb < 8; ++rb) { u32x2 w; w.x = cvtpk(oacc[rb][0] * rl, oacc[rb][1] * rl); w.y = cvtpk(oacc[rb][2] * rl, oacc[rb][3] * rl);
        *(u32x2*)(Orow + c16 * 128 + 16 * rb + 4 * g) = w; } }
}
#undef DSA_TRRD

__device__ __forceinline__ void dsa_phase(DLAS char* lds, const bf16_t* proj, float* Iscr_all, bf16_t* o, int G, int bx, const unsigned char* k8all = nullptr, const unsigned char* v8all = nullptr) {
    int tid = threadIdx.x; asm volatile("" : "+v"(tid)); const int wid = __builtin_amdgcn_readfirstlane(tid >> 6), lane = tid & 63;
    DLAS char* vbuf = lds + wid * WAVE_LDS; DLAS unsigned short* list = (DLAS unsigned short*)(vbuf + 32 * VROW);
    float* Iscr = Iscr_all + ((size_t)bx * 8 + wid) * 4 * S;
    for (int pi = bx; pi < 256; pi += G) {
        const int b = pi & 7, cp = pi >> 3;
        const bf16_t* P = proj + (size_t)b * S * LDP;
        for (int half = 0; half < 2; ++half) {
            const int c = half ? 63 - cp : cp; const int n_adm = 64 * (c + 1); const int nv = n_adm < 256 ? n_adm : 256;
            for (int pass = 0; pass < 2; ++pass) {
                const int tq0 = 64 * c + 8 * wid + 4 * pass;
                if (DSA_DUP == 1 && n_adm > 256) { indexer_wg<0>(P, tq0, n_adm, Iscr, lds + NWAVE_ * WAVE_LDS, tid); }
                if (DSA_DUP == 4 && n_adm > 256) { indexer_wg<1>(P, tq0, n_adm, Iscr, lds + NWAVE_ * WAVE_LDS, tid); }
                if (DSA_DUP == 5 && n_adm > 256) { indexer_wg<2>(P, tq0, n_adm, Iscr, lds + NWAVE_ * WAVE_LDS, tid); __syncthreads(); }
                if (DSA_DUP == 7 && n_adm > 256) { indexer_wg<4>(P, tq0, n_adm, Iscr, lds + NWAVE_ * WAVE_LDS, tid); }
                if (DSA_DUP == 6 && n_adm > 256) { indexer_wg<3>(P, tq0, n_adm, Iscr, lds + NWAVE_ * WAVE_LDS, tid); }
                if (n_adm > 256) { indexer_wg<0>(P, tq0, n_adm, Iscr, lds + NWAVE_ * WAVE_LDS, tid); asm volatile("s_waitcnt vmcnt(0)" ::: "memory"); }
                for (int qq = 0; qq < 4; ++qq) {
#pragma unroll 1
                    for (int rep = 0; rep < (DSA_DUP == 2 ? 2 : 1); ++rep) {
                    if (n_adm > 256) topk256(Iscr + (size_t)qq * S, n_adm, list, vbuf, lane);
                    else { for (int i = lane; i < 256; i += 64) list[i] = (unsigned short)i; }
                    asm volatile("s_waitcnt lgkmcnt(0)" ::: "memory"); }
#pragma unroll 1
                    for (int rep = 0; rep < (DSA_DUP == 3 ? 2 : 1); ++rep)
                    sparse_attn(P, tq0 + qq, list, nv, vbuf, L1_I8 >= 3 ? (bf16_t*)((unsigned char*)o + ((size_t)b * S + tq0 + qq) * LDO) : o + ((size_t)b * S + tq0 + qq) * LDO, lane, k8all + (size_t)b * S * 128, v8all + (size_t)b * S * 128);
                }
            }
        }
    }
}
}
constexpr int NB = 8, SEQ = 4096, DM = 2048, MTOK = NB * SEQ, FF = 8192;
constexpr int N_IN0 = 6144, N_IN1 = 3584, W0SRC = 6152, W1SRC = 3408;
constexpr int NWAVES = 8;
constexpr float RMS_EPS = 1e-6f;
constexpr float QSCALE = 0.08838834764831845f * 1.4426950408889634f;
constexpr size_t MiB = 1u << 20;
constexpr size_t WS_CTL = 0, CTL_ZERO_BYTES = 1 * MiB;
constexpr size_t WS_MOD = 1 * MiB, WS_TAB = 2 * MiB, WS_FLOC = 3 * MiB, WS_BTOT = 4 * MiB;
constexpr size_t WS_WIN0 = 8 * MiB, WS_WOUT0 = 32 * MiB, WS_W1_0 = 40 * MiB, WS_W2_0 = 72 * MiB, WS_WIN1 = 104 * MiB, WS_WOUT1 = 118 * MiB, WS_W1_1 = 126 * MiB, WS_W2_1 = 158 * MiB;
constexpr size_t WS_H = 192 * MiB, WS_Y = 320 * MiB, WS_PROJ = 448 * MiB, WS_O = 832 * MiB, WS_HID = 448 * MiB, WS_END = 960 * MiB;
constexpr size_t WS_WIN1Q = 21 * MiB, WS_H8B = WS_O;
constexpr int N_QKV1 = 2304;
constexpr size_t WS_V8 = 56 * MiB;
constexpr size_t WS_K8 = 26 * MiB;
constexpr size_t WS_X16 = 704 * MiB;
constexpr size_t WS_ISCR = WS_H;
constexpr int CW_BAR = 4096, CW_W1MAX = 8192, CW_W2MAX = 8193, CW_W1SQ = 8194, CW_WOMAX = 8196, CW_W1MAX0 = 8198, CW_W2MAX0 = 8199, CW_W1SQ0 = 8200, CW_CS1 = 12288, CW_CS0 = 16384;
constexpr size_t WS_SIG = WS_TAB + 65536;
constexpr size_t WS_SQP = WS_TAB + 131072;
constexpr size_t WS_ROWS = 5 * MiB, WS_RINV = 5 * MiB + 262144, WS_WINV = WS_TAB + 196608;
constexpr int N_PHASES = 16;
constexpr int RING_OFF = 0, RING_BYTES = 131072;
constexpr int LDSCTL_OFF = RING_BYTES, MISC_OFF = LDSCTL_OFF + 320;
constexpr int LDS_BYTES = 147456;
static_assert(att::LDS_BYTES <= RING_BYTES && att::LDS_SB_BYTES <= RING_BYTES && dsa::WAVE_LDS * NWAVES + dsa::KI_LDS <= RING_BYTES, "phase LDS vs ring");

#define GAS __attribute__((address_space(1)))
#define LAS __attribute__((address_space(3)))
typedef unsigned short bf16;
typedef unsigned v4u __attribute__((ext_vector_type(4)));
typedef unsigned v2u __attribute__((ext_vector_type(2)));
typedef float f32x4 __attribute__((ext_vector_type(4)));
typedef GAS unsigned gu32;
#define RLX_AGENT __ATOMIC_RELAXED, __HIP_MEMORY_SCOPE_AGENT
#define LDS_WAIT() asm volatile("s_waitcnt lgkmcnt(0)" ::: "memory")
#define VM_WAIT() asm volatile("s_waitcnt vmcnt(0)" ::: "memory")
__device__ __forceinline__ unsigned pk2(float lo, float hi) { unsigned r; asm volatile("v_cvt_pk_f16_f32 %0, %1, %2" : "=v"(r) : "v"(lo), "v"(hi)); return r; }
__device__ __forceinline__ float bflo(unsigned w) { return (float)__builtin_bit_cast(_Float16, (unsigned short)(w & 0xffffu)); }
__device__ __forceinline__ float bfhi(unsigned w) { return (float)__builtin_bit_cast(_Float16, (unsigned short)(w >> 16)); }
#define XB_TMO      128
#define XB_XCNT(j)  (256  + 64 * (j))
#define XB_XSUB(j)  (1280 + 64 * (j))
#define XB_XGEN(j)  (2304 + 64 * (j))
#define XB_TOP      3328
#define XB_TOPGEN   3392
#define XCD_BAR_WORDS 3456
#define XB_SPIN_CAP (1u << 18)

__device__ __forceinline__ unsigned xb_ld(unsigned* p)              { return __hip_atomic_load(p, __ATOMIC_RELAXED, __HIP_MEMORY_SCOPE_AGENT); }
__device__ __forceinline__ unsigned xb_add(unsigned* p, unsigned v) { return __hip_atomic_fetch_add(p, v, __ATOMIC_RELAXED, __HIP_MEMORY_SCOPE_AGENT); }
__device__ __forceinline__ unsigned xb_xcc_id() { return (unsigned)__builtin_amdgcn_s_getreg((3 << 11) | 20) & 0xFu; }
#define XB_SPIN(cond, bar) do { unsigned _sp = 0; while (cond) { __builtin_amdgcn_s_sleep(1); \
    if ((++_sp & 255u) == 0u) { if (xb_ld(&(bar)[XB_TMO])) break; if (_sp > XB_SPIN_CAP) { atomicAdd(&(bar)[XB_TMO], 1u); break; } } } } while (0)

struct XcdBarrier {
    unsigned* bar; unsigned x;
    volatile LAS unsigned* st;
};

__device__ __forceinline__ XcdBarrier xcd_barrier_post(unsigned* bar, volatile LAS unsigned* st) {
    XcdBarrier b; b.bar = bar; b.x = xb_xcc_id(); b.st = st;
    if (threadIdx.x == 0) (void)xb_add(&bar[XB_XCNT(b.x)], 1u);
    return b;
}
__device__ __forceinline__ void xcd_barrier_complete(unsigned* bar, unsigned x, unsigned& nloc, unsigned& nx) {
    const unsigned G = gridDim.x * gridDim.y * gridDim.z;
    unsigned sum, cnt, mine, sp = 0u;
    for (;;) {
        sum = 0u; cnt = 0u; mine = 0u;
#pragma unroll
        for (unsigned j = 0; j < 16; ++j) { const unsigned c = xb_ld(&bar[XB_XCNT(j)]); sum += c; cnt += (c > 0u) ? 1u : 0u; mine = (j == x) ? c : mine; }
        if (sum == G) break;
        __builtin_amdgcn_s_sleep(1);
        if ((++sp & 255u) == 0u) { if (xb_ld(&bar[XB_TMO])) break; if (sp > XB_SPIN_CAP) { atomicAdd(&bar[XB_TMO], 1u); break; } }
    }
    nloc = mine > 0u ? mine : 1u; nx = cnt > 0u ? cnt : 1u;
}

__device__ __forceinline__ void xcd_barrier(const XcdBarrier& b) {
    asm volatile("s_waitcnt vmcnt(0)" ::: "memory");
    __syncthreads();
    if (threadIdx.x == 0) {
        unsigned* bar = b.bar;
        __builtin_amdgcn_s_waitcnt(0);
        unsigned nloc = b.st[0], nx = b.st[1];
        if (nloc == 0u) { xcd_barrier_complete(bar, b.x, nloc, nx); b.st[0] = nloc; b.st[1] = nx; }
        const unsigned old = xb_add(&bar[XB_XSUB(b.x)], 1u);
        const unsigned gen = old / nloc;
        if (old + 1u == (gen + 1u) * nloc) {
            __builtin_amdgcn_fence(__ATOMIC_RELEASE, "agent");
            asm volatile("s_waitcnt vmcnt(0)" ::: "memory");
            const unsigned og = xb_add(&bar[XB_TOP], 1u);
            const unsigned tg = og / nx;
            if (og + 1u == (tg + 1u) * nx) xb_add(&bar[XB_TOPGEN], 1u);
            else XB_SPIN(xb_ld(&bar[XB_TOPGEN]) == tg, bar);
            __builtin_amdgcn_fence(__ATOMIC_ACQUIRE, "agent");
            xb_add(&bar[XB_XGEN(b.x)], 1u);
            asm volatile("s_waitcnt vmcnt(0)" ::: "memory");
        } else {
            XB_SPIN(xb_ld(&bar[XB_XGEN(b.x)]) == gen, bar);
            __builtin_amdgcn_fence(__ATOMIC_ACQUIRE, "agent");
            asm volatile("s_waitcnt vmcnt(0)" ::: "memory");
        }
    }
    __syncthreads();
}

struct Args { const void* in[12]; float* out; unsigned char* ws; int ph_lo, ph_hi; };
typedef const __attribute__((address_space(4))) Args* KArgsP;
__device__ __forceinline__ KArgsP kargs() { KArgsP p = (KArgsP)__builtin_amdgcn_kernarg_segment_ptr(); asm volatile("" : "+s"(p)); return p; }
#define KIN_F(i) ((const float*)kargs()->in[i])
#define KIN_I(i) ((const int*)kargs()->in[i])
enum { I_X = 0, I_C = 1, I_POS = 2, I_ADAW = 3, I_ADAB = 4, I_NORMG = 5, I_WOUT = 6, I_WIN0 = 7, I_BF = 8, I_WIN1 = 9, I_W1 = 10, I_W2 = 11 };
struct Frame {
    LAS unsigned char* lds;
    volatile LAS unsigned* MISC;
    gu32* ctl;
    int vcu, G;
    float* out; unsigned char* ws;
};
__device__ __forceinline__ float wave_sum(float v) {
#pragma unroll
    for (int o = 1; o < 64; o <<= 1) v += __shfl_xor(v, o);
    return v;
}
__device__ __forceinline__ float half_sum(float v) {
#pragma unroll
    for (int o = 1; o < 32; o <<= 1) v += __shfl_xor(v, o);
    return v;
}
#define YBLK(r, c) ((((size_t)(r) >> 4) * (DM >> 5) + ((size_t)(c) >> 5)) * 512 + ((size_t)(r) & 15) * 32 + ((size_t)(c) & 31))
__device__ __forceinline__ int srccol(int kind, int n) {
    if (kind == 0) return n;
    if (kind == 1) return n < 3072 ? n : n + 8;
    if (n < 2176) { const int j = n & 127; return (n - j) + (j >> 1) + 64 * (j & 1); }
    if (n < 2304) return n;
    if (n < 3392) { const int j = n & 63; return (n - j) + (j >> 1) + 32 * (j & 1); }
    if (n < 3408) return n;
    return -1;
}
template <int WMODE = 0>
__device__ __forceinline__ float p0_transpose_item(const float* W, int K, int Nsrc, int Ndst, bf16* WT, int kind, LAS float* scr, int item, int lane, float qs = 1.f) {
    float sq = 0.f;
    const int nblk = Ndst / 32, kb = item / nblk, nb = item % nblk, k0 = 64 * kb, n0 = 32 * nb;
    const int sc = srccol(kind, n0 + (lane & 31));
    float tv[32];
#pragma unroll
    for (int i = 0; i < 32; ++i) { const int kk = 2 * i + (lane >> 5); tv[i] = sc >= 0 ? W[(size_t)(k0 + kk) * Nsrc + sc] : 0.f; }
#pragma unroll
    for (int i = 0; i < 32; ++i) { const int kk = 2 * i + (lane >> 5); scr[kk * 33 + (lane & 31)] = tv[i]; }
    LDS_WAIT(); asm volatile("" ::: "memory");
    const int c = lane & 7;
#pragma unroll
    for (int j = 0; j < 4; ++j) { const int n = (lane >> 3) + 8 * j; const LAS float* s = scr + (8 * c) * 33 + n;
        v4u o; o.x = pk2(s[0 * 33], s[1 * 33]); o.y = pk2(s[2 * 33], s[3 * 33]); o.z = pk2(s[4 * 33], s[5 * 33]); o.w = pk2(s[6 * 33], s[7 * 33]);
        if (WMODE == 2) { v2u o8; o8.x = pk_i8x4s(s[0 * 33], s[1 * 33], s[2 * 33], s[3 * 33], qs, sq); o8.y = pk_i8x4s(s[4 * 33], s[5 * 33], s[6 * 33], s[7 * 33], qs, sq);
            *(GAS v2u*)((unsigned char*)WT + (size_t)(n0 + n) * K + k0 + 8 * c) = o8; }
        else if (WMODE == 1) { unsigned d0 = 0u, d1 = 0u; const float z = 512.f;
            d0 = (unsigned)__builtin_amdgcn_cvt_pk_fp8_f32(s[0 * 33] * z, s[1 * 33] * z, (int)d0, false); d0 = (unsigned)__builtin_amdgcn_cvt_pk_fp8_f32(s[2 * 33] * z, s[3 * 33] * z, (int)d0, true);
            d1 = (unsigned)__builtin_amdgcn_cvt_pk_fp8_f32(s[4 * 33] * z, s[5 * 33] * z, (int)d1, false); d1 = (unsigned)__builtin_amdgcn_cvt_pk_fp8_f32(s[6 * 33] * z, s[7 * 33] * z, (int)d1, true);
            v2u o8; o8.x = d0; o8.y = d1; *(GAS v2u*)((unsigned char*)WT + (size_t)(n0 + n) * K + k0 + 8 * c) = o8; }
        else *(GAS v4u*)(WT + (size_t)(n0 + n) * K + k0 + 8 * c) = o; }
    LDS_WAIT(); asm volatile("" ::: "memory");
    return sq;
}
__device__ __forceinline__ void p0_prologue(Frame& F) {
    int tid_ = threadIdx.x; asm volatile("" : "+v"(tid_)); const int f_tid = tid_, f_lane = tid_ & 63, f_wave = __builtin_amdgcn_readfirstlane(tid_ >> 6);
    if (blockIdx.x == 0 && f_tid < 96) {
        const int i = f_tid < 64 ? f_tid : f_tid - 64; const double r = f_tid < 64 ? 0.8659643233600653 : 0.7498942093324559;
        double v = 0.15915494309189535; for (int j = 0; j < i; ++j) v *= r;
        const float h = (float)v; float* tab = (float*)(F.ws + WS_TAB); tab[2 * f_tid] = h; tab[2 * f_tid + 1] = (float)(v - (double)h);
    }
    {
        LAS float* cs = (LAS float*)(F.lds + RING_OFF); LAS float* part = cs + NB * DM;
        const float* cin = KIN_F(I_C);
        { float cv[NB * DM / (NWAVES * 64)];
#pragma unroll
          for (int j = 0; j < NB * DM / (NWAVES * 64); ++j) cv[j] = cin[f_tid + j * (NWAVES * 64)];
#pragma unroll
          for (int j = 0; j < NB * DM / (NWAVES * 64); ++j) { const float v = cv[j]; cs[f_tid + j * (NWAVES * 64)] = v / (1.f + __expf(-v)); } }
        __syncthreads();
        float* mod = (float*)(F.ws + WS_MOD); const float* ada_w = KIN_F(I_ADAW); const float* ada_b = KIN_F(I_ADAB);
        const int cg = f_tid & 7, kg = f_tid >> 3;
        for (int u = F.vcu; u < 768; u += F.G) {
            const int l = u / 384, cb = (u % 384) * 32;
            f32x4 acc[NB];
#pragma unroll
            for (int b = 0; b < NB; ++b) acc[b] = (f32x4){0.f, 0.f, 0.f, 0.f};
            const float bias_ = f_tid < 256 ? ada_b[l * 12288 + cb + (f_tid & 31)] : 0.f;
            const float* wp = ada_w + (size_t)l * DM * 12288 + cb + 4 * cg;
#pragma unroll 8
            for (int k = kg; k < DM; k += 64) { const f32x4 w = *(const f32x4*)(wp + (size_t)k * 12288);
#pragma unroll
                for (int b = 0; b < NB; ++b) acc[b] += w * cs[b * DM + k]; }
#pragma unroll
            for (int b = 0; b < NB; ++b)
#pragma unroll
                for (int e = 0; e < 4; ++e) { float v = acc[b][e]; v += __shfl_xor(v, 8); v += __shfl_xor(v, 16); v += __shfl_xor(v, 32); acc[b][e] = v; }
            if (f_lane < 8) {
#pragma unroll
                for (int b = 0; b < NB; ++b) *(LAS f32x4*)(part + (f_wave * NB + b) * 32 + 4 * cg) = acc[b]; }
            __syncthreads();
            if (f_tid < 256) { const int b = f_tid >> 5, col = f_tid & 31; float s = bias_;
#pragma unroll
                for (int w = 0; w < NWAVES; ++w) s += part[(w * NB + b) * 32 + col];
                mod[((size_t)l * NB + b) * 12288 + cb + col] = s; }
            __syncthreads();
        }
    }
    LAS float* scr = (LAS float*)(F.lds + RING_OFF + f_wave * 16384);
    const int gw = F.vcu * NWAVES + f_wave, NGW = F.G * NWAVES;
    constexpr int I_IN0 = 32 * (N_IN0 / 32), I_OUT = 32 * (DM / 32), I_1 = 32 * (FF / 32), I_2 = (FF / 64) * (DM / 32), I_IN1 = 32 * (N_IN1 / 32);
    constexpr int NITEMS = I_IN0 + I_IN1 + 2 * (I_OUT + I_1 + I_2);
    for (int it = gw; it < NITEMS; it += NGW) {
        int r = it;
        if (r < I_IN0) { if (!IN0_I8) p0_transpose_item(KIN_F(I_WIN0), DM, W0SRC, N_IN0, (bf16*)(F.ws + WS_WIN0), 1, scr, r, f_lane); continue; } r -= I_IN0;
        if (r < I_IN1) { if (!IN1_I8 || (r % (N_IN1 / 32)) >= N_QKV1 / 32) p0_transpose_item(KIN_F(I_WIN1), DM, W1SRC, N_IN1, (bf16*)(F.ws + WS_WIN1), 2, scr, r, f_lane); continue; } r -= I_IN1;
        if (r < I_OUT) { p0_transpose_item(KIN_F(I_WOUT), DM, DM, DM, (bf16*)(F.ws + WS_WOUT0), 0, scr, r, f_lane); continue; } r -= I_OUT;
        if (r < I_OUT) { if (L1_I8 < 3) p0_transpose_item(KIN_F(I_WOUT) + (size_t)DM * DM, DM, DM, DM, (bf16*)(F.ws + WS_WOUT1), 0, scr, r, f_lane); continue; } r -= I_OUT;
        if (r < I_1) { if (!L0_I8) p0_transpose_item(KIN_F(I_W1), DM, FF, FF, (bf16*)(F.ws + WS_W1_0), 0, scr, r, f_lane); continue; } r -= I_1;
        if (r < I_1) { if (!L1_I8) p0_transpose_item(KIN_F(I_W1) + (size_t)DM * FF, DM, FF, FF, (bf16*)(F.ws + WS_W1_1), 0, scr, r, f_lane); continue; } r -= I_1;
        if (r < I_2) { if (L0_I8 < 2) p0_transpose_item(KIN_F(I_W2), FF, DM, DM, (bf16*)(F.ws + WS_W2_0), 0, scr, r, f_lane); continue; } r -= I_2;
        if (L1_I8 < 2) p0_transpose_item<(FFN2_FP8 != 0) ? 1 : 0>(KIN_F(I_W2) + (size_t)FF * DM, FF, DM, DM, (bf16*)(F.ws + WS_W2_1), 0, scr, r, f_lane);
    }
#define WQ_EN(t) ((t) < 3 ? (L1_I8 > (t)) : (t) < 5 ? (L0_I8 > (t) - 3) : (t) == 5 ? (IN0_I8 != 0) : (IN1_I8 != 0))
#define WQ_SRC(t) ((t) == 0 ? KIN_F(I_W1) + (size_t)DM * FF : (t) == 1 ? KIN_F(I_W2) + (size_t)DM * FF : (t) == 2 ? KIN_F(I_WOUT) + (size_t)DM * DM : (t) == 3 ? KIN_F(I_W1) : (t) == 4 ? KIN_F(I_W2) : (t) == 5 ? KIN_F(I_WIN0) : KIN_F(I_WIN1))
    if (WQ_SIGMA) {
        for (int sl = F.vcu; sl < 256; sl += F.G) { f32x4 v[7][2]; float ss[7];
#pragma unroll
            for (int t = 0; t < 7; ++t) if (WQ_EN(t)) { const f32x4* w = (const f32x4*)WQ_SRC(t); v[t][0] = w[sl * 1024 + f_tid]; v[t][1] = w[sl * 1024 + f_tid + 512]; }
#pragma unroll
            for (int t = 0; t < 7; ++t) if (WQ_EN(t)) { float a = 0.f;
#pragma unroll
                for (int j = 0; j < 2; ++j) a += (v[t][j].x * v[t][j].x + v[t][j].y * v[t][j].y) + (v[t][j].z * v[t][j].z + v[t][j].w * v[t][j].w);
#pragma unroll
                for (int o = 1; o < 64; o <<= 1) a += __shfl_xor(a, o);
                ss[t] = a; }
            __syncthreads();
            if (f_lane == 0) {
#pragma unroll
                for (int t = 0; t < 7; ++t) if (WQ_EN(t)) F.MISC[32 + 8 * t + f_wave] = __builtin_bit_cast(unsigned, ss[t]); }
            __syncthreads();
            if (f_tid < 7 && WQ_EN(f_tid)) { float tot = 0.f;
#pragma unroll
                for (int w8 = 0; w8 < NWAVES; ++w8) tot += __builtin_bit_cast(float, (unsigned)F.MISC[32 + 8 * f_tid + w8]);
                ((float*)(F.ws + WS_SIG))[f_tid * 256 + sl] = tot; } }
        return; }
#pragma unroll 1
    for (int t = 0; t < 7; ++t) { if (t < 3 ? (L1_I8 <= t) : t < 5 ? (L0_I8 <= t - 3) : t == 5 ? !IN0_I8 : !IN1_I8) continue;
        const f32x4* w = (const f32x4*)(t == 0 ? KIN_F(I_W1) + (size_t)DM * FF : t == 1 ? KIN_F(I_W2) + (size_t)DM * FF : t == 2 ? KIN_F(I_WOUT) + (size_t)DM * DM : t == 3 ? KIN_F(I_W1) : t == 4 ? KIN_F(I_W2) : t == 5 ? KIN_F(I_WIN0) : KIN_F(I_WIN1)); float mx = 0.f;
        if (WQ_SIGMA) {
            for (int sl = F.vcu; sl < 256; sl += F.G) { float ss = 0.f;
#pragma unroll
                for (int j = 0; j < 2; ++j) { const f32x4 v = w[sl * 1024 + f_tid + 512 * j]; ss += (v.x * v.x + v.y * v.y) + (v.z * v.z + v.w * v.w); }
#pragma unroll
                for (int o = 1; o < 64; o <<= 1) ss += __shfl_xor(ss, o);
                __syncthreads();
                if (f_lane == 0) F.MISC[32 + f_wave] = __builtin_bit_cast(unsigned, ss);
                __syncthreads();
                if (f_tid == 0) { float tot = 0.f;
#pragma unroll
                    for (int w8 = 0; w8 < NWAVES; ++w8) tot += __builtin_bit_cast(float, (unsigned)F.MISC[32 + w8]);
                    ((float*)(F.ws + WS_SIG))[t * 256 + sl] = tot; } }
            continue; }
        const unsigned n4 = (unsigned)((t == 2 ? (size_t)DM * DM : (size_t)DM * FF) / 4), stride = (unsigned)F.G * (NWAVES * 64);
#pragma unroll 8
        for (unsigned i = (unsigned)F.vcu * (NWAVES * 64) + f_tid; i < n4; i += stride) { const f32x4 v = w[i]; mx = fmaxf(fmaxf(mx, fmaxf(fabsf(v.x), fabsf(v.y))), fmaxf(fabsf(v.z), fabsf(v.w))); }
#pragma unroll
        for (int o = 1; o < 64; o <<= 1) mx = fmaxf(mx, __shfl_xor(mx, o));
        if (f_lane == 0) (void)__hip_atomic_fetch_max((unsigned*)F.ctl + (t == 0 ? CW_W1MAX : t == 1 ? CW_W2MAX : t == 2 ? CW_WOMAX : t == 3 ? CW_W1MAX0 : CW_W2MAX0), __builtin_bit_cast(unsigned, mx), RLX_AGENT); }
}
__device__ __forceinline__ float wq_scale(Frame& F, int t, int cw_max, int lane) {
    if (WQ_SIGMA) { const float* sg = (const float*)(F.ws + WS_SIG) + t * 256; float v = (sg[lane] + sg[lane + 64]) + (sg[lane + 128] + sg[lane + 192]);
#pragma unroll
        for (int o = 1; o < 64; o <<= 1) v += __shfl_xor(v, o);
        return 127.f / fmaxf(4.f * sqrtf(v * (1.f / 1048576.f)), 1e-30f); }
    const float wmax = __builtin_bit_cast(float, __hip_atomic_load((unsigned*)F.ctl + cw_max, RLX_AGENT)); return 127.f / fmaxf(wmax, 1e-30f);
}
__device__ __forceinline__ float tr64_item(const float* W, int K, int Nsrc, int Ndst, unsigned char* WT, int kind, LAS unsigned char* scr, int item, int lane, float qs) {
    const int nblk = Ndst / 64, kb = item / nblk, nb = item % nblk, k0 = 64 * kb, n0 = 64 * nb;
    const int sc0 = (kind == 1 && n0 >= 3072) ? n0 + 8 : n0;
    const int kg = lane >> 4, ng = lane & 15;
    const float* src = W + (size_t)(k0 + 4 * kg) * Nsrc + sc0 + 4 * ng;
    f32x4 tv[4][4];
#pragma unroll
    for (int p = 0; p < 4; ++p)
#pragma unroll
        for (int i = 0; i < 4; ++i) tv[p][i] = *(const f32x4*)(src + (size_t)(16 * p + i) * Nsrc);
    float sq = 0.f;
#pragma unroll
    for (int p = 0; p < 4; ++p) { unsigned r[4];
#pragma unroll
        for (int i = 0; i < 4; ++i) r[i] = pk_i8x4s(tv[p][i].x, tv[p][i].y, tv[p][i].z, tv[p][i].w, qs, sq);
        const unsigned a = __builtin_amdgcn_perm(r[1], r[0], 0x05010400u), b = __builtin_amdgcn_perm(r[1], r[0], 0x07030602u);
        const unsigned c = __builtin_amdgcn_perm(r[3], r[2], 0x05010400u), d = __builtin_amdgcn_perm(r[3], r[2], 0x07030602u);
        const unsigned t0 = __builtin_amdgcn_perm(c, a, 0x05040100u), t1 = __builtin_amdgcn_perm(c, a, 0x07060302u), t2 = __builtin_amdgcn_perm(d, b, 0x05040100u), t3 = __builtin_amdgcn_perm(d, b, 0x07060302u);
        LAS unsigned char* wp = scr + (4 * ng) * 68 + 16 * p + 4 * kg;
        *(LAS unsigned*)(wp) = t0; *(LAS unsigned*)(wp + 68) = t1; *(LAS unsigned*)(wp + 136) = t2; *(LAS unsigned*)(wp + 204) = t3; }
    LDS_WAIT(); asm volatile("" ::: "memory");
    const int pc = lane & 3;
#pragma unroll
    for (int q = 0; q < 4; ++q) { const int n = (lane >> 2) + 16 * q; const LAS unsigned* rp = (const LAS unsigned*)(scr + n * 68 + 16 * pc);
        v4u o; o.x = rp[0]; o.y = rp[1]; o.z = rp[2]; o.w = rp[3];
        *(GAS v4u*)(WT + (size_t)(n0 + n) * K + k0 + 16 * pc) = o; }
    LDS_WAIT(); asm volatile("" ::: "memory");
    return sq;
}
__device__ __forceinline__ void p1_sq_store(Frame& F, float sq, int l, int lane, int wave) {
    unsigned isq = (unsigned)sq;
#pragma unroll
    for (int o = 1; o < 64; o <<= 1) isq += (unsigned)__shfl_xor((int)isq, o);
    __syncthreads();
    if (lane == 0) F.MISC[32 + wave] = isq;
    __syncthreads();
    if (threadIdx.x == 0) { unsigned tot = 0u;
#pragma unroll
        for (int w8 = 0; w8 < NWAVES; ++w8) tot += F.MISC[32 + w8];
        ((unsigned*)(F.ws + WS_SQP))[l * 256 + F.vcu] = tot; }
}
__device__ __forceinline__ void p1_w_int8(Frame& F) {
    int tid_ = threadIdx.x; asm volatile("" : "+v"(tid_)); const int f_lane = tid_ & 63, f_wave = __builtin_amdgcn_readfirstlane(tid_ >> 6);
    __syncthreads();
    LAS float* scr = (LAS float*)(F.lds + RING_OFF + f_wave * 16384); LAS unsigned char* scr8 = (LAS unsigned char*)scr;
    const int gw = F.vcu * NWAVES + f_wave, NGW = F.G * NWAVES;
    float qsv[7];
    { const int cwm[7] = {CW_W1MAX, CW_W2MAX, CW_WOMAX, CW_W1MAX0, CW_W2MAX0, CW_WOMAX, CW_WOMAX};
#pragma unroll
      for (int t = 0; t < 7; ++t) qsv[t] = WQ_EN(t) ? wq_scale(F, t, cwm[t], f_lane) : 1.f; }
    { const float qs = qsv[0];
      float sq = 0.f;
      for (int it = gw; it < (DM / 64) * (FF / 64); it += NGW) sq += tr64_item(KIN_F(I_W1) + (size_t)DM * FF, DM, FF, FF, F.ws + WS_W1_1, 0, scr8, it, f_lane, qs);
      p1_sq_store(F, sq, 1, f_lane, f_wave); }
    if (L1_I8 >= 2) { const float qs = qsv[1];
      for (int it = gw; it < (FF / 64) * (DM / 64); it += NGW) (void)tr64_item(KIN_F(I_W2) + (size_t)FF * DM, FF, DM, DM, F.ws + WS_W2_1, 0, scr8, it, f_lane, qs); }
    if (L0_I8) { const float qs = qsv[3];
      float sq = 0.f;
      for (int it = gw; it < (DM / 64) * (FF / 64); it += NGW) sq += tr64_item(KIN_F(I_W1), DM, FF, FF, F.ws + WS_W1_0, 0, scr8, it, f_lane, qs);
      p1_sq_store(F, sq, 0, f_lane, f_wave); }
    if (L0_I8 >= 2) { const float qs = qsv[4];
      for (int it = gw; it < (FF / 64) * (DM / 64); it += NGW) (void)tr64_item(KIN_F(I_W2), FF, DM, DM, F.ws + WS_W2_0, 0, scr8, it, f_lane, qs); }
    if (IN0_I8) { const float qs = qsv[5];
      for (int it = gw; it < (DM / 64) * (N_IN0 / 64); it += NGW) (void)tr64_item(KIN_F(I_WIN0), DM, W0SRC, N_IN0, F.ws + WS_WIN0, 1, scr8, it, f_lane, qs);
      if (F.vcu == 0 && tid_ == 0) *(float*)(F.ws + WS_WINV) = 1.f / qs; }
    if (IN1_I8) { const float qs = qsv[6];
      for (int it = gw; it < 32 * (N_QKV1 / 32); it += NGW) (void)p0_transpose_item<2>(KIN_F(I_WIN1), DM, W1SRC, N_QKV1, (bf16*)(F.ws + WS_WIN1Q), 2, scr, it, f_lane, qs);
      if (F.vcu == 0 && tid_ == 0) ((float*)(F.ws + WS_WINV))[1] = 1.f / qs; }
    if (L1_I8 >= 3) { const float qs = qsv[2];
      for (int it = gw; it < (DM / 64) * (DM / 64); it += NGW) (void)tr64_item(KIN_F(I_WOUT) + (size_t)DM * DM, DM, DM, DM, F.ws + WS_WOUT1, 0, scr8, it, f_lane, qs); }
}
__device__ __forceinline__ void p2_colsum(Frame& F, const unsigned char* Wq, int* cs) {
    int tid_ = threadIdx.x; asm volatile("" : "+v"(tid_)); const int f_lane = tid_ & 63, f_wave = __builtin_amdgcn_readfirstlane(tid_ >> 6);
    for (int n = F.vcu * NWAVES + f_wave; n < DM; n += F.G * NWAVES) {
        const v4u* rowp = (const v4u*)(Wq + (size_t)n * FF); int sum = 0;
#pragma unroll
        for (int i = 0; i < FF / 1024; ++i) { const v4u x = rowp[f_lane + 64 * i];
#pragma unroll
            for (int e = 0; e < 4; ++e) { const int w = (int)x[e]; sum += ((w << 24) >> 24) + ((w << 16) >> 24) + ((w << 8) >> 24) + (w >> 24); } }
#pragma unroll
        for (int o = 1; o < 64; o <<= 1) sum += __shfl_xor(sum, o);
        if (f_lane == 0) cs[n] = sum;
    }
}
__device__ __forceinline__ float half_max(float v) {
#pragma unroll
    for (int o = 1; o < 32; o <<= 1) v = fmaxf(v, __shfl_xor(v, o));
    return v;
}
template <bool HAS_Y, bool HAS_NEXT, bool FG, int H8 = 0, int XI = 0, int XO = 0>
__device__ __forceinline__ void thin_phase(Frame& F, const float* xin, const bf16* y, float* xout, bf16* hout,
                                           const float* gate, const float* gainY, const float* gainN, const float* scN, const float* shN, int sqw = 0, unsigned char* h8alt = nullptr) {
    int tid_ = threadIdx.x; asm volatile("" : "+v"(tid_)); const int f_tid = tid_, f_lane = tid_ & 63, f_wave = __builtin_amdgcn_readfirstlane(tid_ >> 6);
    LAS float* vA = (LAS float*)(F.lds + RING_OFF); LAS float* vB = vA + DM; LAS float* vC = vB + DM; LAS float* Wfg = vC + DM; LAS float* lf = Wfg + 8 * DM;
    bool first = true;
    float mwq2 = 0.f;
    if (H8 == 2) { const unsigned* sp = (const unsigned*)(F.ws + WS_SQP) + sqw * 256; float v = 0.f;
        for (int i = f_lane; i < F.G; i += 64) v += (float)sp[i];
#pragma unroll
        for (int o = 1; o < 64; o <<= 1) v += __shfl_xor(v, o);
        mwq2 = v * (1.f / ((float)DM * (float)FF)); }
    for (int u = F.vcu; u < MTOK / 128; u += F.G) {
        const int r0 = 128 * u, b = r0 / SEQ;
        __syncthreads();
        for (int c = f_tid; c < DM; c += NWAVES * 64) {
            if (HAS_Y) vA[c] = gate[(size_t)b * 12288 + c] * gainY[c];
            if (HAS_NEXT) { vB[c] = gainN[c] * (1.f + scN[(size_t)b * 12288 + c]); vC[c] = shN[(size_t)b * 12288 + c]; } }
        if (FG && first) { const float* w0 = KIN_F(I_WIN0); float wv[32];
            int ft = f_tid; asm volatile("" : "+v"(ft));
#pragma unroll
            for (int q = 0; q < 32; ++q) { const int i = ft + q * (NWAVES * 64); wv[q] = w0[(size_t)(i >> 3) * W0SRC + 3072 + (i & 7)]; }
#pragma unroll
            for (int q = 0; q < 32; ++q) { const int i = ft + q * (NWAVES * 64); Wfg[(i & 7) * DM + (i >> 3)] = wv[q]; } }
        first = false;
        __syncthreads();
        const int hrow = f_lane >> 5, q_ = f_lane & 31;
#pragma unroll 1
        for (int i = 0; i < 16; i += 2) {
            int q = q_; if (FG && H8) asm volatile("" : "+v"(q));
            const int rl = f_wave * 16 + i + hrow; const size_t row = (size_t)(r0 + rl);
            f32x4 xv[16];
#pragma unroll
            for (int k = 0; k < 16; ++k) {
                if (XI) { const v2u w = __builtin_nontemporal_load((const v2u*)((const bf16*)xin + row * DM + 4 * q + 128 * k)); xv[k] = (f32x4){bflo(w.x), bfhi(w.x), bflo(w.y), bfhi(w.y)}; }
                else xv[k] = __builtin_nontemporal_load((const f32x4*)(xin + row * DM + 4 * q + 128 * k)); }
            if (HAS_Y) {
                v2u yw[16];
#pragma unroll
                for (int k = 0; k < 16; ++k) yw[k] = __builtin_nontemporal_load((const v2u*)(y + YBLK(row, 4 * q + 128 * k)));
                float ss = 0.f;
#pragma unroll
                for (int k = 0; k < 16; ++k) { const float a0 = bflo(yw[k].x), a1 = bfhi(yw[k].x), a2 = bflo(yw[k].y), a3 = bfhi(yw[k].y); ss += (a0 * a0 + a1 * a1) + (a2 * a2 + a3 * a3); }
                const float ry = 1.f / sqrtf(half_sum(ss) * (1.f / DM) + RMS_EPS);
#pragma unroll
                for (int k = 0; k < 16; ++k) { const f32x4 a = *(const LAS f32x4*)(vA + 4 * q + 128 * k); const f32x4 yv = (f32x4){bflo(yw[k].x), bfhi(yw[k].x), bflo(yw[k].y), bfhi(yw[k].y)};
                    xv[k] += a * yv * ry;
                    if (XO) { v2u w; w.x = pk2(xv[k].x, xv[k].y); w.y = pk2(xv[k].z, xv[k].w); __builtin_nontemporal_store(w, (v2u*)((bf16*)xout + row * DM + 4 * q + 128 * k)); }
                    else __builtin_nontemporal_store(xv[k], (f32x4*)(xout + row * DM + 4 * q + 128 * k)); }
            }
            if (HAS_NEXT) {
                float ss = 0.f;
#pragma unroll
                for (int k = 0; k < 16; ++k) ss += (xv[k].x * xv[k].x + xv[k].y * xv[k].y) + (xv[k].z * xv[k].z + xv[k].w * xv[k].w);
                const float rx = 1.f / sqrtf(half_sum(ss) * (1.f / DM) + RMS_EPS);
                float fa[8];
#pragma unroll
                for (int h = 0; h < 8; ++h) fa[h] = 0.f;
                if (H8) { float mx = 0.f, s2 = 0.f;
#pragma unroll
                    for (int k = 0; k < 16; ++k) { const f32x4 bb = *(const LAS f32x4*)(vB + 4 * q + 128 * k), cc = *(const LAS f32x4*)(vC + 4 * q + 128 * k);
                        const f32x4 hv = xv[k] * rx * bb + cc; xv[k] = hv; mx = fmaxf(fmaxf(mx, fmaxf(fabsf(hv.x), fabsf(hv.y))), fmaxf(fabsf(hv.z), fabsf(hv.w))); s2 += (hv.x * hv.x + hv.y * hv.y) + (hv.z * hv.z + hv.w * hv.w);
                        if (H8 == 4) { v2u w; w.x = pk2(hv.x, hv.y); w.y = pk2(hv.z, hv.w); *(v2u*)(hout + row * DM + 4 * q + 128 * k) = w; }
                        if ((k & 3) == 3) __builtin_amdgcn_sched_barrier(0); }
                    const float hmx = fmaxf(half_max(mx), 1e-30f); const float qs = 127.f / hmx;
                    if ((H8 == 3 || H8 == 4) && q == 0) ((float*)(F.ws + WS_RINV))[row] = hmx * (1.f / 127.f);
                    if (H8 == 2) {
                        s2 = half_sum(s2);
                        if (q == 0) ((float*)(F.ws + WS_ROWS))[row] = (HID_U8 ? 255.f / 20.f : 127.f / 16.f) / fmaxf(qs * qs * s2 * mwq2, 1e-30f); }
#pragma unroll
                    for (int k = 0; k < 16; ++k) *(unsigned*)((H8 == 4 ? h8alt : (unsigned char*)hout) + row * DM + 4 * q + 128 * k) = pk_i8x4(xv[k].x, xv[k].y, xv[k].z, xv[k].w, qs);
                    if (FG) {
                        typedef float f32x2_ __attribute__((ext_vector_type(2)));
                        f32x2_ fa2[8]; f32x4 wc[8];
#pragma unroll
                        for (int h = 0; h < 8; ++h) { fa2[h] = (f32x2_){0.f, 0.f}; wc[h] = *(const LAS f32x4*)(Wfg + h * DM + 4 * q); }
#pragma unroll
                        for (int k = 0; k < 16; ++k) { f32x4 wn[8];
                            if (k + 1 < 16) {
#pragma unroll
                                for (int h = 0; h < 8; ++h) wn[h] = *(const LAS f32x4*)(Wfg + h * DM + 4 * q + 128 * (k + 1)); }
                            const f32x4 hv = xv[k]; const f32x2_ h01 = {hv.x, hv.y}, h23 = {hv.z, hv.w};
#pragma unroll
                            for (int h = 0; h < 8; ++h) { fa2[h] += h01 * (f32x2_){wc[h].x, wc[h].y}; fa2[h] += h23 * (f32x2_){wc[h].z, wc[h].w}; }
                            if (k + 1 < 16) {
#pragma unroll
                                for (int h = 0; h < 8; ++h) wc[h] = wn[h]; }
                            __builtin_amdgcn_sched_barrier(0); }
#pragma unroll
                        for (int h = 0; h < 8; ++h) fa[h] = fa2[h].x + fa2[h].y; }
                } else
#pragma unroll
                for (int k = 0; k < 16; ++k) { const f32x4 bb = *(const LAS f32x4*)(vB + 4 * q + 128 * k), cc = *(const LAS f32x4*)(vC + 4 * q + 128 * k);
                    const f32x4 hv = xv[k] * rx * bb + cc;
                    v2u w; w.x = pk2(hv.x, hv.y); w.y = pk2(hv.z, hv.w); *(v2u*)(hout + row * DM + 4 * q + 128 * k) = w;
                    if (FG) {
#pragma unroll
                        for (int h = 0; h < 8; ++h) { const f32x4 ww = *(const LAS f32x4*)(Wfg + h * DM + 4 * q + 128 * k); fa[h] += (hv.x * ww.x + hv.y * ww.y) + (hv.z * ww.z + hv.w * ww.w); } } }
                if (FG) {
#pragma unroll
                    for (int h = 0; h < 8; ++h) fa[h] = half_sum(fa[h]);
                    if (q < 8) { float v = 0.f;
#pragma unroll
                        for (int h = 0; h < 8; ++h) v = (q == h) ? fa[h] : v;
                        v += KIN_F(I_BF)[q];
                        lf[rl * 8 + q] = fminf(v, 0.f) - __logf(1.f + __expf(-fabsf(v))); }
                }
            }
        }
        if (FG) {
            __syncthreads();
            if (f_tid < 64) { const int h = f_tid & 7, part = f_tid >> 3; float run = 0.f; float loc[16];
#pragma unroll
                for (int i = 0; i < 16; ++i) { run += lf[(part * 16 + i) * 8 + h]; loc[i] = run; }
                float pre = 0.f;
#pragma unroll
                for (int pp = 0; pp < 8; ++pp) { const float t = __shfl(run, pp * 8 + h); if (pp < part) pre += t; }
                float* Floc = (float*)(F.ws + WS_FLOC) + ((size_t)(b * 8 + h) * SEQ + (r0 % SEQ) + part * 16);
#pragma unroll
                for (int i = 0; i < 16; ++i) Floc[i] = pre + loc[i];
                if (part == 7) ((float*)(F.ws + WS_BTOT))[(b * 8 + h) * 32 + (r0 % SEQ) / 128] = pre + run; }
        }
    }
}
__device__ __forceinline__ void mixer0_phase(Frame& F, char* lds) {
    int tid_ = threadIdx.x; asm volatile("" : "+v"(tid_)); const int f_tid = tid_, f_lane = tid_ & 63, f_wave = __builtin_amdgcn_readfirstlane(tid_ >> 6);
    using att::BlockRef; using att::Seam; using att::TIN; using att::TOUT; using att::QB; using att::LDQ; using att::LDO; using att::SKV; using att::WINDOW;
    const ::bf16* proj = (const ::bf16*)(F.ws + WS_PROJ); ::bf16* o = (::bf16*)(F.ws + WS_O);
    const float* Floc = (const float*)(F.ws + WS_FLOC); const float* Btot = (const float*)(F.ws + WS_BTOT);
    float* fb = (float*)(lds + att::LDS_FB); float* pre = fb + SKV;
#pragma unroll 1
    for (int frep = ((MK_DOUBLE == 503 || MK_DOUBLE == 504) ? 0 : 1); frep < 2; ++frep)
    for (int it = blockIdx.x; it < 256; it += F.G) {
        const int bh = it >> 2, qt = it & 3, b = bh >> 3, h = bh & 7;
        const int qbs[4] = {qt, 7 - qt, 8 + qt, 15 - qt};
        __syncthreads();
        int ft0 = f_tid; asm volatile("" : "+v"(ft0));
        if (ft0 < 64) { const float v = ft0 < 32 ? Btot[bh * 32 + ft0] : 0.f; float inc = v;
#pragma unroll
            for (int o = 1; o < 32; o <<= 1) { const float t = __shfl_up(inc, o); if (ft0 >= o) inc += t; }
            if (ft0 < 32) pre[ft0] = inc - v; if (ft0 == 31) pre[32] = inc; }
        const __hip_bfloat16* base = (const __hip_bfloat16*)proj + (size_t)b * SEQ * LDQ + (size_t)(h * 4) * 512;
        int Wfox = WINDOW; float qa0 = 0.f, qd0 = 0.f, qa1 = 0.f, qd1 = 0.f;
        if (FOX_WIN) {
            typedef _Float16 h2_ __attribute__((ext_vector_type(2)));
            float kk = 0.f; int ft = f_tid; asm volatile("" : "+v"(ft));
#pragma unroll 4
            for (int i = 0; i < 8; ++i) { const int r = ft + 512 * i;
                const __hip_bfloat16* rp = base + 32 * 512 + (size_t)(r >> 4) * (LDQ / 32) * 512 + (r & 15) * 32; float ssq = 0.f;
#pragma unroll
                for (int cb = 0; cb < 4; ++cb)
#pragma unroll
                    for (int e = 0; e < 4; ++e) { const v4u x = *(const v4u*)(rp + cb * 512 + e * 8);
#pragma unroll
                        for (int w = 0; w < 4; ++w) { const h2_ hh = __builtin_bit_cast(h2_, x[w]); ssq = __builtin_amdgcn_fdot2(hh, hh, ssq, false); } }
                kk = fmaxf(kk, ssq); }
#pragma unroll 1
            for (int i = 0; i < 2; ++i) { const int qi_ = 2 * i + (ft >> 8); const int qb_ = qi_ == 0 ? qt : qi_ == 1 ? 7 - qt : qi_ == 2 ? 8 + qt : 15 - qt;
                const int r = qb_ * QB + (ft & 255);
                const __hip_bfloat16* rp = base + (size_t)(r >> 4) * (LDQ / 32) * 512 + (r & 15) * 32; float ssq = 0.f, dqk = 0.f;
#pragma unroll
                for (int cb = 0; cb < 4; ++cb)
#pragma unroll
                    for (int e = 0; e < 4; ++e) { const v4u x = *(const v4u*)(rp + cb * 512 + e * 8), y = *(const v4u*)(rp + 32 * 512 + cb * 512 + e * 8);
#pragma unroll
                        for (int w = 0; w < 4; ++w) { const h2_ hq = __builtin_bit_cast(h2_, x[w]), hk = __builtin_bit_cast(h2_, y[w]); ssq = __builtin_amdgcn_fdot2(hq, hq, ssq, false); dqk = __builtin_amdgcn_fdot2(hq, hk, dqk, false); } }
                if (i == 0) { qa0 = ssq; qd0 = dqk; } else { qa1 = ssq; qd1 = dqk; } }
#pragma unroll
            for (int o = 1; o < 64; o <<= 1) kk = fmaxf(kk, __shfl_xor(kk, o));
            if ((ft & 63) == 0) pre[40 + (ft >> 6)] = kk;
        }
        __syncthreads();
        for (int s = f_tid; s < SKV; s += NWAVES * 64) fb[s] = -(Floc[(size_t)bh * SEQ + s] + pre[s >> 7]) * 11.313708498984761f;
        if (FOX_WIN) { int ftq = f_tid; asm volatile("" : "+v"(ftq)); float km = 0.f;
#pragma unroll
            for (int w = 0; w < NWAVES; ++w) km = fmaxf(km, pre[40 + w]);
            float tq = fmaxf(sqrtf(qa0 * km) - qd0, sqrtf(qa1 * km) - qd1);
#pragma unroll
            for (int o = 1; o < 64; o <<= 1) tq = fmaxf(tq, __shfl_xor(tq, o));
            if ((ftq & 63) == 0) pre[48 + (ftq >> 6)] = tq;
            __syncthreads(); }
        if (FOX_WIN) {
            int ft2 = f_tid; asm volatile("" : "+v"(ft2));
            if (ft2 < 64) { float tm = -3.0e38f;
#pragma unroll
                for (int w = 0; w < NWAVES; ++w) tm = fmaxf(tm, pre[48 + w]);
                const float T = tm * 0.08838834764831845f + 30.f;
                const int n = ft2 + 1; float Dn = -3.0e38f;
                if (n <= 32) { for (int j = 0; j + n <= 32; ++j) Dn = fmaxf(Dn, pre[j + n] - pre[j]); }
                const unsigned long long ok = __ballot(n <= 32 && Dn <= -T);
                int W = SKV; if (ok) { const int n0 = __builtin_ctzll(ok) + 1; W = 128 * (n0 + 1); if (W > SKV) W = SKV; }
                if (ft2 == 0) ((volatile int*)pre)[56] = W; }
            __syncthreads();
            Wfox = __builtin_amdgcn_readfirstlane(((volatile int*)pre)[56]);
        }
        __hip_bfloat16* obase = (__hip_bfloat16*)o + (size_t)b * SEQ * LDO + h * 128;
#define FOX_REF(qb) BlockRef<TIN, TOUT>{base + (size_t)(qb) * QB * LDQ, base + 32 * 512, base + 64 * 512, obase + (size_t)(qb) * QB * LDO, (qb) * QB}
        BlockRef<TIN, TOUT> cur = FOX_REF(qbs[0]);
        Seam<TIN> S;
        att::causal_swa_prime<TIN, TOUT>(cur, Wfox, lds, S);
#pragma unroll 1
        for (int k = 0; k < 4; ++k) {
            const int qn = qbs[k < 3 ? k + 1 : k];
            const BlockRef<TIN, TOUT> nxt = FOX_REF(qn);
            if (MK_DOUBLE == 503 && frep == 0) att::causal_swa_block<TIN, TOUT, false>(cur, nxt, SKV, Wfox, lds, S, (unsigned)(uintptr_t)fb); else
            att::causal_swa_block<TIN, TOUT>(cur, nxt, SKV, Wfox, lds, S, (unsigned)(uintptr_t)fb);
            cur = nxt;
        }
#undef FOX_REF
    }
    for (int it = blockIdx.x; it < 256; it += F.G) {
        const int bh = it >> 2, qt = it & 3, b = bh >> 3, h = bh & 7;
        const int qbs[4] = {qt, 7 - qt, 8 + qt, 15 - qt};
        const __hip_bfloat16* base = (const __hip_bfloat16*)proj + (size_t)b * SEQ * LDQ + (size_t)(96 + h * 4) * 512;
        __hip_bfloat16* obase = (__hip_bfloat16*)o + (size_t)b * SEQ * LDO + 1024 + h * 128;
#pragma unroll 1
        for (int k = 0; k < 4; ++k) { const int qb = qbs[k];
            __syncthreads();
            att::sb_block(base + (size_t)qb * QB * LDQ, base + 32 * 512, base + 64 * 512, obase + (size_t)qb * QB * LDO, qb * QB, lds, (volatile int*)(lds + LDSCTL_OFF - RING_OFF)); }
    }
}

#if !MK_PER_PHASE
#define GRID_BAR() xcd_barrier(bar)
#else
#define GRID_BAR() do { } while (0)
#endif
#define IN(k) (lo <= (k) && (k) < hi)
#define BOTH(k) (IN(k) && IN((k) + 1))

template <int l>
__device__ __forceinline__ void layer_phases(Frame& F, const XcdBarrier& bar, unsigned char* lds, int lo, int hi) {
    unsigned char* const ws = F.ws;
    bf16* const Hb = (bf16*)(ws + WS_H); bf16* const Yb = (bf16*)(ws + WS_Y); bf16* const PROJ = (bf16*)(ws + WS_PROJ); bf16* const Ob = (bf16*)(ws + WS_O); bf16* const HID = (bf16*)(ws + WS_HID);
    const float* const mod = (const float*)(ws + WS_MOD);

        const int pb = 2 + 7 * l;
        const float* const modl = mod + (size_t)l * NB * 12288;
#define NG_ (KIN_F(I_NORMG) + (size_t)l * 4 * DM)
#define XS_ (X16 ? (float*)(ws + WS_X16) : F.out)
        if (IN(pb)) {
            if constexpr (l == 0 && HID_U8 != 0) { if (L1_I8 >= 2) p2_colsum(F, ws + WS_W2_1, (int*)F.ctl + CW_CS1); if (L0_I8 >= 2) p2_colsum(F, ws + WS_W2_0, (int*)F.ctl + CW_CS0); }
            if constexpr (l == 0) { pg8::Gemm g{Hb, (const bf16*)(ws + WS_WIN0), MTOK, N_IN0, DM}; pg8::StaticOrder S; S.init(MTOK, N_IN0, F.G, (int)blockIdx.x);
                if constexpr (IN0_I8 != 0) { g.K = DM / 2;
                    pg8::EpiBf16<6, true> E{PROJ, N_IN0, 3072, 4096, QSCALE, nullptr, (const float*)(ws + WS_RINV), (const float*)(ws + WS_WINV)};
                    pg8::gemm_phase<pg8::EpiBf16<6, true>, pg8::StaticOrder, PG8_ALIGN, PG8_SP2, false, false, true>(F.lds + RING_OFF, g, S, E); }
                else {
                pg8::EpiBf16<0, true> E{PROJ, N_IN0, 3072, 4096, QSCALE};
#pragma unroll 1
                for (int rep_ = 0; rep_ < ((MK_DOUBLE == pb) ? 2 : 1); ++rep_) { pg8::gemm_phase<pg8::EpiBf16<0, true>, pg8::StaticOrder, PG8_ALIGN, PG8_SP2>(F.lds + RING_OFF, g, S, E); if (MK_DOUBLE == pb && rep_ == 0) GRID_BAR(); } } }
            else if constexpr (IN1_I8 != 0) {
                { pg8::Gemm g{Hb, (const bf16*)(ws + WS_WIN1) + (size_t)N_QKV1 * DM, MTOK, N_IN1 - N_QKV1, DM}; pg8::StaticOrder S; S.init(MTOK, N_IN1 - N_QKV1, F.G, (int)blockIdx.x);
                  pg8::EpiRope E{PROJ, N_IN1, KIN_I(I_POS), (const float*)(ws + WS_TAB), QSCALE, N_QKV1};
                  pg8::gemm_phase<pg8::EpiRope, pg8::StaticOrder, PG8_ALIGN, PG8_SP2>(F.lds + RING_OFF, g, S, E); }
                { pg8::Gemm g{(const bf16*)(ws + WS_H8B), (const bf16*)(ws + WS_WIN1Q), MTOK, N_QKV1, DM / 2}; pg8::DealOrder S; S.init(MTOK, N_QKV1, F.G, (int)blockIdx.x);
                  pg8::EpiRopeT<true> E{PROJ, N_IN1, KIN_I(I_POS), (const float*)(ws + WS_TAB), QSCALE, 0, (const float*)(ws + WS_RINV), (const float*)(ws + WS_WINV) + 1, ws + WS_K8, ws + WS_V8};
                  pg8::gemm_phase<pg8::EpiRopeT<true>, pg8::DealOrder, PG8_ALIGN, PG8_SP2, false, false, true>(F.lds + RING_OFF, g, S, E); } }
            else { pg8::Gemm g{Hb, (const bf16*)(ws + WS_WIN1), MTOK, N_IN1, DM}; pg8::StaticOrder S; S.init(MTOK, N_IN1, F.G, (int)blockIdx.x);
                pg8::EpiRope E{PROJ, N_IN1, KIN_I(I_POS), (const float*)(ws + WS_TAB), QSCALE};
                pg8::gemm_phase<pg8::EpiRope, pg8::StaticOrder, PG8_ALIGN, PG8_SP2>(F.lds + RING_OFF, g, S, E); }
            if (BOTH(pb)) GRID_BAR();
        }
        if (IN(pb + 1)) {
#pragma unroll 1
            for (int rep = 0; rep < ((MK_DOUBLE == pb + 1) ? 2 : 1); ++rep) {
            if constexpr (l == 0) mixer0_phase(F, (char*)lds + RING_OFF);
            else dsa::dsa_phase((LAS char*)(F.lds + RING_OFF), PROJ, (float*)(ws + WS_ISCR), Ob, F.G, (int)blockIdx.x, ws + WS_K8, ws + WS_V8);
            if (BOTH(pb + 1)) GRID_BAR(); }
        }
        if (IN(pb + 2)) {
            pg8::Gemm g{Ob, (const bf16*)(ws + (l == 0 ? WS_WOUT0 : WS_WOUT1)), MTOK, DM, DM}; pg8::StaticOrder S; S.init(MTOK, DM, F.G, (int)blockIdx.x);
            if constexpr (l == 1 && L1_I8 >= 3) { g.K = DM / 2;
                pg8::EpiBf16<4, true> E4{Yb, DM, 0, 0, 1.f};
                pg8::gemm_phase<pg8::EpiBf16<4, true>, pg8::StaticOrder, PG8_ALIGN, PG8_SP2, false, false, true>(F.lds + RING_OFF, g, S, E4);
                if (BOTH(pb + 2)) GRID_BAR(); }
            else {
            pg8::EpiBf16<0, true> E{Yb, DM, 0, 0, 1.f};
#pragma unroll 1
            for (int rep_ = 0; rep_ < ((MK_DOUBLE == pb + 2) ? 2 : 1); ++rep_) {
            pg8::gemm_phase<pg8::EpiBf16<0, true>, pg8::StaticOrder, PG8_ALIGN, PG8_SP2>(F.lds + RING_OFF, g, S, E);
            if (BOTH(pb + 2)) GRID_BAR(); } }
        }
        if (IN(pb + 3)) {
#pragma unroll 1
            for (int rep = 0; rep < ((MK_DOUBLE == pb + 3) ? 2 : 1); ++rep) {
            thin_phase<true, true, false, (l == 1 ? (L1_I8 >= 2 ? 2 : L1_I8 ? 1 : 0) : L0_I8), (X16 && l == 1) ? 1 : 0, X16 ? 1 : 0>(F, l == 0 ? KIN_F(I_X) : XS_, Yb, XS_, Hb, modl + 2 * DM, NG_ + 1 * DM, NG_ + 2 * DM, modl + 4 * DM, modl + 3 * DM, l);
            if (BOTH(pb + 3)) GRID_BAR(); }
        }
        if (IN(pb + 4)) {
            pg8::Gemm g{Hb, (const bf16*)(ws + (l == 0 ? WS_W1_0 : WS_W1_1)), MTOK, FF, DM}; pg8::StaticOrder S; S.init(MTOK, FF, F.G, (int)blockIdx.x);
            if constexpr ((l == 1 && L1_I8 == 1) || (l == 0 && L0_I8 == 1)) { g.K = DM / 2;
                pg8::EpiBf16<2, true> E{HID, FF, 0, 0, 1.f};
#pragma unroll 1
                for (int rep = 0; rep < ((MK_DOUBLE == pb + 4) ? 2 : 1); ++rep) {
                pg8::gemm_phase<pg8::EpiBf16<2, true>, pg8::StaticOrder, PG8_ALIGN, PG8_SP2, false, false, true>(F.lds + RING_OFF, g, S, E);
                if (BOTH(pb + 4)) GRID_BAR(); } }
            else if constexpr ((l == 1 && L1_I8 >= 2) || (l == 0 && L0_I8 >= 2)) { g.K = DM / 2;
                pg8::EpiI8Hid E{(unsigned char*)HID, FF, (const float*)(ws + WS_ROWS)};
#pragma unroll 1
                for (int rep = 0; rep < ((MK_DOUBLE == pb + 4) ? 2 : 1); ++rep) {
                pg8::gemm_phase<pg8::EpiI8Hid, pg8::StaticOrder, PG8_ALIGN, PG8_SP2, false, false, true>(F.lds + RING_OFF, g, S, E);
                if (BOTH(pb + 4)) GRID_BAR(); } }
            else if constexpr (l == 0 || !FFN2_FP8) { pg8::EpiBf16<1, true> E{HID, FF, 0, 0, 1.f};
#pragma unroll 1
                for (int rep = 0; rep < ((MK_DOUBLE == pb + 4) ? 2 : 1); ++rep) {
                pg8::gemm_phase<pg8::EpiBf16<1, true>, pg8::StaticOrder, PG8_ALIGN, PG8_SP2>(F.lds + RING_OFF, g, S, E);
                if (BOTH(pb + 4)) GRID_BAR(); } }
            else { pg8::EpiF8Hid E{(unsigned char*)HID, FF};
                pg8::gemm_phase<pg8::EpiF8Hid, pg8::StaticOrder, PG8_ALIGN, PG8_SP2>(F.lds + RING_OFF, g, S, E);
                if (BOTH(pb + 4)) GRID_BAR(); }
        }
        if (IN(pb + 5)) {
            pg8::StaticOrder S; S.init(MTOK, DM, F.G, (int)blockIdx.x);
            pg8::EpiBf16<0, true> E{Yb, DM, 0, 0, 1.f};
            if constexpr ((l == 1 && L1_I8 >= 2) || (l == 0 && L0_I8 >= 2)) { pg8::Gemm g{HID, (const bf16*)(ws + (l == 0 ? WS_W2_0 : WS_W2_1)), MTOK, DM, FF / 2};
                pg8::EpiBf16<(HID_U8 ? 5 : 4), true> E4{Yb, DM, 0, 0, 1.f, (const int*)F.ctl + (l == 0 ? CW_CS0 : CW_CS1)};
#pragma unroll 1
                for (int rep_ = 0; rep_ < ((MK_DOUBLE == pb + 5) ? 2 : 1); ++rep_) {
                pg8::gemm_phase<pg8::EpiBf16<(HID_U8 ? 5 : 4), true>, pg8::StaticOrder, PG8_ALIGN, PG8_SP2, true, false, true>(F.lds + RING_OFF, g, S, E4);
                if (BOTH(pb + 5)) GRID_BAR(); } }
            else if constexpr (l == 0 || !FFN2_FP8) { pg8::Gemm g{HID, (const bf16*)(ws + (l == 0 ? WS_W2_0 : WS_W2_1)), MTOK, DM, FF};
#pragma unroll 1
                for (int rep_ = 0; rep_ < ((MK_DOUBLE == pb + 5) ? 2 : 1); ++rep_) {
                pg8::gemm_phase<pg8::EpiBf16<0, true>, pg8::StaticOrder, PG8_ALIGN, PG8_SP2, true>(F.lds + RING_OFF, g, S, E);
                if (BOTH(pb + 5)) GRID_BAR(); } }
            else { pg8::Gemm g{HID, (const bf16*)(ws + WS_W2_1), MTOK, DM, FF / 2};
                pg8::gemm_phase<pg8::EpiBf16<0, true>, pg8::StaticOrder, PG8_ALIGN, PG8_SP2, true, true>(F.lds + RING_OFF, g, S, E);
                if (BOTH(pb + 5)) GRID_BAR(); }
        }
        if (IN(pb + 6)) {
            if constexpr (l == 0) thin_phase<true, true, false, (IN1_I8 ? 4 : 0), X16 ? 1 : 0, X16 ? 1 : 0>(F, XS_, Yb, XS_, Hb, modl + 5 * DM, NG_ + 3 * DM, KIN_F(I_NORMG) + 4 * DM, mod + (size_t)NB * 12288 + 1 * DM, mod + (size_t)NB * 12288 + 0 * DM, 0, ws + WS_H8B);
            else thin_phase<true, false, false, 0, X16 ? 1 : 0, 0>(F, XS_, Yb, F.out, nullptr, modl + 5 * DM, NG_ + 3 * DM, nullptr, nullptr, nullptr);
            if (BOTH(pb + 6)) GRID_BAR();
        }

}
__global__ void __launch_bounds__(NWAVES * 64, 2) mk_fwd(Args args) {
    extern __shared__ __attribute__((aligned(16))) unsigned char lds[];
    Frame F;
    F.lds = (LAS unsigned char*)lds;
    F.MISC = (volatile LAS unsigned*)(F.lds + MISC_OFF);
    F.G = gridDim.x; { const int bx = blockIdx.x; F.vcu = (F.G % 8 == 0) ? (bx % 8) * (F.G / 8) + bx / 8 : bx; }
    unsigned char* ws = args.ws; F.ws = ws;
    F.ctl = (gu32*)(ws + WS_CTL);
    F.out = args.out;
    for (int u = threadIdx.x; u < (LDS_BYTES - LDSCTL_OFF) / 4; u += NWAVES * 64) ((LAS unsigned*)(F.lds + LDSCTL_OFF))[u] = 0u;
    __syncthreads();
    XcdBarrier bar; bar.bar = (unsigned*)(F.ctl + CW_BAR); bar.x = 0; bar.st = nullptr;
#if !MK_PER_PHASE
    bar = xcd_barrier_post((unsigned*)(F.ctl + CW_BAR), F.MISC + 8);
#endif
    const int lo = args.ph_lo, hi = args.ph_hi;
    bf16* const Hb = (bf16*)(ws + WS_H); bf16* const Yb = (bf16*)(ws + WS_Y); bf16* const PROJ = (bf16*)(ws + WS_PROJ); bf16* const Ob = (bf16*)(ws + WS_O); bf16* const HID = (bf16*)(ws + WS_HID);
    const float* const mod = (const float*)(ws + WS_MOD);

    if (IN(0)) {
#pragma unroll 1
        for (int rep = 0; rep < ((MK_DOUBLE == 0) ? 2 : 1); ++rep) { p0_prologue(F); if (BOTH(0)) GRID_BAR(); } }
    if (IN(1)) {
#pragma unroll 1
        for (int rep = 0; rep < ((MK_DOUBLE == 1) ? 2 : 1); ++rep) {
        thin_phase<false, true, true, (IN0_I8 ? 3 : 0)>(F, KIN_F(I_X), nullptr, nullptr, Hb, nullptr, nullptr, KIN_F(I_NORMG) + 0 * DM, mod + 1 * DM, mod + 0 * DM);
        if (L1_I8 || L0_I8 || IN0_I8 || IN1_I8) p1_w_int8(F);
#ifdef P1DUP
        p1_w_int8(F);
#endif
        if (BOTH(1)) GRID_BAR(); }
    }
    layer_phases<0>(F, bar, lds, lo, hi);
    layer_phases<1>(F, bar, lds, lo, hi);
}

extern "C" void kernel_launch(void* const* d_in, const int* in_sizes, int n_in, void* d_out, int out_size, void* d_ws, size_t ws_size, hipStream_t stream) {
    static int grid = 0;
    if (grid == 0) {
        if (n_in != 12 || in_sizes[0] != MTOK * DM || out_size != MTOK * DM || ws_size < WS_END) { fprintf(stderr, "kernel_launch: unexpected shapes (n_in %d, in0 %d, out %d, ws %zu < %zu); nothing launched\n", n_in, n_in > 0 ? in_sizes[0] : -1, out_size, ws_size, (size_t)WS_END); grid = -1; return; }
        int dev = 0, cus = 0, per_cu = 0;
        if (hipGetDevice(&dev) != hipSuccess || hipDeviceGetAttribute(&cus, hipDeviceAttributeMultiprocessorCount, dev) != hipSuccess) { grid = -1; return; }
        if (hipFuncSetAttribute((const void*)mk_fwd, hipFuncAttributeMaxDynamicSharedMemorySize, LDS_BYTES) != hipSuccess) { fprintf(stderr, "kernel_launch: hipFuncSetAttribute failed\n"); grid = -1; return; }
        if (hipOccupancyMaxActiveBlocksPerMultiprocessor(&per_cu, (const void*)mk_fwd, NWAVES * 64, LDS_BYTES) != hipSuccess || per_cu < 1) { fprintf(stderr, "kernel_launch: occupancy query reports %d workgroups per CU\n", per_cu); grid = -1; (void)hipGetLastError(); return; }
        (void)hipGetLastError();
        grid = cus;
        if (grid > 256) grid = 256;
    }
    if (grid < 0) return;
    if (hipMemsetAsync((char*)d_ws + WS_CTL, 0, CTL_ZERO_BYTES, stream) != hipSuccess) return;
    Args a{};
    for (int i = 0; i < 12; ++i) a.in[i] = d_in[i];
    a.out = (float*)d_out; a.ws = (unsigned char*)d_ws;
#if MK_PER_PHASE
    for (int ph = 0; ph < N_PHASES; ++ph) { a.ph_lo = ph; a.ph_hi = ph + 1; hipLaunchKernelGGL(mk_fwd, dim3(grid), dim3(NWAVES * 64), LDS_BYTES, stream, a);
#if MK_DIAG
        { DiagIn D{(const float*)d_in[0], (const float*)d_in[1], (const float*)d_in[3], (const float*)d_in[4], (const float*)d_in[5], (const float*)d_in[6], (const float*)d_in[7], (const float*)d_in[8], (const float*)d_in[10], (const float*)d_in[11], (float*)d_out, (unsigned char*)d_ws};
#define DG(w, l, f) hipLaunchKernelGGL(diag_gen, dim3(64), dim3(64), 0, stream, D, w, l, f)
          if (DIAG_SET == 3) { if (ph == 5) DG(10, 0, 0); }
          if (DIAG_SET == 5) { if (ph == 10) hipLaunchKernelGGL(diag_syn, dim3(3), dim3(64), 0, stream, (unsigned char*)d_ws, SYN_A, SYN_B, SYN_C); }
          if (DIAG_SET == 4) { if (ph == 10) hipLaunchKernelGGL(diag_rows, dim3(64), dim3(64), 0, stream, (unsigned char*)d_ws, 2); }
          if (DIAG_SET == 0) { if (ph == 0) DG(1, 0, 0); if (ph == 1) { DG(2, 0, 1); DG(3, 0, 2); } }
          if (DIAG_SET == 1) { if (ph == 2) DG(4, 0, 0); if (ph == 4) DG(5, 0, 1); if (ph == 11) DG(5, 1, 1); if (ph == 5) DG(6, 0, 2); if (ph == 12) DG(6, 1, 2); }
          if (DIAG_SET == 2) { if (ph == 6) DG(7, 0, 0); if (ph == 13) DG(7, 1, 0); if (ph == 7) DG(8, 0, 1); if (ph == 14) DG(8, 1, 1); if (ph == 8) DG(9, 0, 2); }
        }
#endif
    }
#if MK_DIAG
    hipLaunchKernelGGL(diag_apply, dim3(1), dim3(64), 0, stream, (unsigned char*)d_ws, (float*)d_out);
#endif
#else
    a.ph_lo = 0; a.ph_hi = N_PHASES; hipLaunchKernelGGL(mk_fwd, dim3(grid), dim3(NWAVES * 64), LDS_BYTES, stream, a);
#endif
}
```
